# Optimizing an MI355X kernel written in HIP

```python
import jax, jax.numpy as jnp
from jax import lax
import numpy as np

D_MODEL = 2048
BATCH = 2
SEQ = 4096
DEPTH = 1

D_MIX = D_MODEL
RWKV_W = D_MIX // 2
HGRN_W = D_MIX - RWKV_W
RWKV_HEAD = 64
RWKV_HEADS = RWKV_W // RWKV_HEAD
HGRN_EXPAND = 128
HGRN_HEADS = HGRN_W // HGRN_EXPAND
HGRN_DV = HGRN_W // HGRN_HEADS
DECAY_LORA = 96
A_LORA = 96
CHUNK = 64
NORM_EPS = 1e-6
LNX_EPS = 64e-5

N_RWKV_COLS = 4 * RWKV_W + DECAY_LORA + A_LORA
N_HGRN_COLS = 4 * HGRN_W
N_IN = N_RWKV_COLS + N_HGRN_COLS

kernel_name = "hymba_rwkv7_hgrn2_layer"


def rmsnorm(x, g, eps=NORM_EPS):
    xf = x.astype(jnp.float32)
    y = xf * lax.rsqrt(jnp.mean(xf * xf, axis=-1, keepdims=True) + eps)
    return (y * g.astype(jnp.float32)).astype(x.dtype)


def token_shift(p):
    return jnp.pad(p[:, :-1], ((0, 0), (1, 0), (0, 0)))


def rwkv7_mix(pr, mu, w0, w2, a0, a2, k_k, k_a, r_k, lnx_w, lnx_b):
    B, T, _ = pr.shape
    H, N = RWKV_HEADS, RWKV_HEAD
    pm = pr + mu * (token_shift(pr) - pr)
    idx = np.cumsum([RWKV_W, RWKV_W, RWKV_W, RWKV_W, DECAY_LORA])
    r, k, v, gate, wd, ad = jnp.split(pm, idx, axis=-1)
    w_log = -jax.nn.softplus(-(w0 + jnp.tanh(wd) @ w2)) - 0.5
    decay = jnp.exp(-jnp.exp(w_log))
    a = jax.nn.sigmoid(a0 + ad @ a2)
    kk = (k * k_k).reshape(B, T, H, N)
    kk = kk / jnp.maximum(jnp.linalg.norm(kk, axis=-1, keepdims=True), 1e-12)
    k = k * (1.0 + (a - 1.0) * k_a)
    hs = lambda z: z.reshape(B, T, H, N)
    r4, k4, v4, d4, a4 = hs(r), hs(k), hs(v), hs(decay), hs(a)
    avec = -kk
    bvec = kk * a4

    def step(S, inp):
        rt, wt, kt, vt, at, bt = inp
        Sa = jnp.einsum('bhvk,bhk->bhv', S, at)
        S = S * wt[:, :, None, :] + Sa[..., None] * bt[:, :, None, :] + vt[..., None] * kt[:, :, None, :]
        y = jnp.einsum('bhvk,bhk->bhv', S, rt)
        return S, y

    tm = lambda z: jnp.transpose(z, (1, 0, 2, 3))
    S0 = jnp.zeros((B, H, N, N), jnp.float32)
    _, y = lax.scan(step, S0, (tm(r4), tm(d4), tm(k4), tm(v4), tm(avec), tm(bvec)))
    y = jnp.transpose(y, (1, 0, 2, 3))
    mean = jnp.mean(y, axis=-1, keepdims=True)
    var = jnp.mean(jnp.square(y - mean), axis=-1, keepdims=True)
    y = (y - mean) * lax.rsqrt(var + LNX_EPS)
    y = y.reshape(B, T, RWKV_W) * lnx_w + lnx_b
    bonus = jnp.sum(r4 * k4 * r_k, axis=-1, keepdims=True) * v4
    y = y + bonus.reshape(B, T, RWKV_W)
    return y * jax.nn.silu(gate)


def hgrn2_mix(ph, lb, norm_g):
    B, T, _ = ph.shape
    H, DK, DV, C = HGRN_HEADS, HGRN_EXPAND, HGRN_DV, CHUNK
    nC = T // C
    q, f_raw, i, gate = jnp.split(ph, 4, axis=-1)
    f = lb + (1.0 - lb) * jax.nn.sigmoid(f_raw)
    k = 1.0 - f
    logf = jnp.log(f)

    def chunked(z, d):
        return jnp.transpose(z.reshape(B, nC, C, H, d), (1, 0, 3, 2, 4))

    qc, kc, vc = chunked(q, DK), chunked(k, DK), chunked(i, DV)
    Gc = jnp.cumsum(chunked(logf, DK), axis=-2)
    causal = (jnp.arange(C)[:, None] >= jnp.arange(C)[None, :])[None, None, :, :, None]

    def step(S, inp):
        qt, kt, vt, Gt = inp
        G_last = Gt[:, :, -1, :]
        inter = jnp.einsum('bhtk,bhkv->bhtv', qt * jnp.exp(Gt), S)
        Dlt = Gt[:, :, :, None, :] - Gt[:, :, None, :, :]
        E = jnp.where(causal, jnp.exp(jnp.where(causal, Dlt, 0.0)), 0.0)
        A = jnp.einsum('bhtk,bhsk,bhtsk->bhts', qt, kt, E)
        intra = jnp.einsum('bhts,bhsv->bhtv', A, vt)
        kdec = kt * jnp.exp(G_last[:, :, None, :] - Gt)
        S = S * jnp.exp(G_last)[..., None] + jnp.einsum('bhsk,bhsv->bhkv', kdec, vt)
        return S, inter + intra

    S0 = jnp.zeros((B, H, DK, DV), jnp.float32)
    _, o = lax.scan(step, S0, (qc, kc, vc, Gc))
    o = jnp.transpose(o, (1, 0, 3, 2, 4)).reshape(B, T, H, DV)
    o = o * lax.rsqrt(jnp.mean(o * o, axis=-1, keepdims=True) + NORM_EPS)
    o = o.reshape(B, T, HGRN_W) * norm_g
    return o * jax.nn.silu(gate)


def setup_inputs(seed: int = 0) -> dict:
    key = jax.random.key(seed)
    ks = jax.random.split(key, 20)
    f32 = jnp.float32
    nrm = lambda k, s, sc: (jax.random.normal(k, s, f32) * sc)
    return {
        "x": nrm(ks[0], (BATCH, SEQ, D_MODEL), 1.0),
        "norm_g": 1.0 + nrm(ks[1], (DEPTH, D_MODEL), 0.02),
        "w_in": nrm(ks[2], (DEPTH, D_MODEL, N_IN), D_MODEL ** -0.5),
        "mu": jax.random.uniform(ks[3], (DEPTH, N_RWKV_COLS), f32, 0.0, 1.0),
        "w0": jax.random.uniform(ks[4], (DEPTH, RWKV_W), f32, -4.0, 0.0),
        "w2": nrm(ks[5], (DEPTH, DECAY_LORA, RWKV_W), 0.1),
        "a0": nrm(ks[6], (DEPTH, RWKV_W), 0.1),
        "a2": nrm(ks[7], (DEPTH, A_LORA, RWKV_W), 0.1),
        "k_k": 0.85 + nrm(ks[8], (DEPTH, RWKV_W), 0.02),
        "k_a": 1.0 + nrm(ks[9], (DEPTH, RWKV_W), 0.02),
        "r_k": nrm(ks[10], (DEPTH, RWKV_HEADS, RWKV_HEAD), 0.1),
        "lnx_w": 1.0 + nrm(ks[11], (DEPTH, RWKV_W), 0.02),
        "lnx_b": nrm(ks[12], (DEPTH, RWKV_W), 0.01),
        "hgrn_norm_g": 1.0 + nrm(ks[13], (DEPTH, HGRN_W), 0.02),
        "lb_param": nrm(ks[14], (DEPTH + 1, HGRN_W), 0.1),
        "w_out": nrm(ks[15], (DEPTH, D_MIX, D_MODEL), D_MIX ** -0.5),
        "final_g": 1.0 + nrm(ks[16], (D_MODEL,), 0.02),
    }


def reference(x, norm_g, w_in, mu, w0, w2, a0, a2, k_k, k_a, r_k, lnx_w, lnx_b,
              hgrn_norm_g, lb_param, w_out, final_g):
    f32 = jnp.float32
    lbs = jnp.cumsum(jax.nn.softmax(lb_param.astype(f32), axis=0), axis=0)
    h = x
    for l in range(DEPTH):
        hn = rmsnorm(h, norm_g[l])
        p = (hn @ w_in[l]).astype(f32)
        pr, ph = p[..., :N_RWKV_COLS], p[..., N_RWKV_COLS:]
        y_r = rwkv7_mix(pr, mu[l].astype(f32), w0[l].astype(f32), w2[l].astype(f32),
                        a0[l].astype(f32), a2[l].astype(f32), k_k[l].astype(f32),
                        k_a[l].astype(f32), r_k[l].astype(f32), lnx_w[l].astype(f32),
                        lnx_b[l].astype(f32))
        y_h = hgrn2_mix(ph, lbs[l], hgrn_norm_g[l].astype(f32))
        y = jnp.concatenate([y_r, y_h], axis=-1).astype(h.dtype)
        h = h + y @ w_out[l]
    return rmsnorm(h, final_g)
```

```cpp
#include <hip/hip_runtime.h>
#include <hip/hip_cooperative_groups.h>
#include <cstdio>
#include <cstdint>
namespace cg = cooperative_groups;

#ifndef MK_SINGLE
#define MK_SINGLE 1
#endif

typedef unsigned short bf16_t;
using bf16x8 = __attribute__((ext_vector_type(8))) short;
using f32x4 = __attribute__((ext_vector_type(4))) float;
using u32x2 = __attribute__((ext_vector_type(2))) unsigned;
using u32x4 = __attribute__((ext_vector_type(4))) unsigned;

constexpr int NTOK = 8192, TSEQ = 4096, DM = 2048, NINP = 8448;
constexpr int BM = 256, BK = 64, HALF = 128, NXCD = 8, WGM = 8, HT = HALF * BK, SHM_B = 8 * HT * 2;

constexpr int LDS_ST = 149504, LDS_BYTES = LDS_ST + 32;
constexpr size_t OFF_HN = 0;
constexpr size_t OFF_WINT = 33554432;
constexpr size_t OFF_WOUTT = OFF_WINT + 34603008;
constexpr size_t OFF_Q = OFF_WOUTT + 8388608;
constexpr size_t OFF_F = OFF_Q + 16777216;
constexpr size_t OFF_I = OFF_F + 33554432;
constexpr size_t OFF_GH = OFF_I + 16777216;
constexpr size_t OFF_RKVG = OFF_GH + 16777216;
constexpr size_t OFF_WDAD = OFF_RKVG + 67108864;
constexpr size_t OFF_YR = OFF_WDAD + 8388608;
constexpr size_t OFF_SC = OFF_YR + 16777216;
constexpr size_t OFF_LA = OFF_SC + 524288;
constexpr size_t OFF_LB = OFF_LA + 4194304;
constexpr size_t OFF_WP3 = OFF_LB + 1048576;
constexpr size_t OFF_BAR = OFF_WP3 + 8388608;
constexpr size_t OFF_FLG = OFF_BAR + 16384;
constexpr size_t WS_END = OFF_FLG + 16384;
constexpr size_t OFF_RING_R = OFF_LA;
constexpr size_t OFF_RING_H = OFF_WDAD;
static_assert(OFF_RING_R + (size_t)32 * 4 * 8 * 12544 <= OFF_BAR, "RWKV ring overruns");
static_assert((size_t)16 * 4 * 8 * 13824 <= 8388608, "HGRN ring overruns");
__host__ __device__ constexpr size_t wp_off(int ks) { return ks == 0 ? OFF_WDAD : (ks == 1 ? OFF_YR : (ks == 2 ? OFF_YR + 8388608 : OFF_WP3)); }

struct Params {
    const float* x; const float* norm_g; const float* w_in; const float* mu; const float* w0; const float* w2;
    const float* a0; const float* a2; const float* k_k; const float* k_a; const float* r_k; const float* lnx_w;
    const float* lnx_b; const float* hg; const float* lbp; const float* w_out; const float* final_g;
    float* out; unsigned char* ws; unsigned* bar;
};

extern __shared__ __attribute__((aligned(16))) unsigned char smem_raw[];

__device__ __forceinline__ bf16_t f2bf(float f) { unsigned u = __float_as_uint(f); u += 0x7fffu + ((u >> 16) & 1u); return (bf16_t)(u >> 16); }
__device__ __forceinline__ float bf2f(bf16_t h) { return __uint_as_float(((unsigned)h) << 16); }
__device__ __forceinline__ unsigned pack2(float a, float b) { return (unsigned)f2bf(a) | ((unsigned)f2bf(b) << 16); }
__device__ __forceinline__ float wave_sum(float v) {
#pragma unroll
    for (int o = 32; o > 0; o >>= 1) v += __shfl_xor(v, o);
    return v;
}
template <int CTRL> __device__ __forceinline__ float dpp_f(float v) {
    return __int_as_float(__builtin_amdgcn_update_dpp(0, __float_as_int(v), CTRL, 0xf, 0xf, false));
}
__device__ __forceinline__ float allred16(float v) {
    v += dpp_f<0xB1>(v);
    v += dpp_f<0x4E>(v);
    v += dpp_f<0x124>(v);
    v += dpp_f<0x128>(v);
    return v;
}
typedef __attribute__((address_space(1))) unsigned gu32;
typedef __attribute__((address_space(1))) unsigned long long gu64;
typedef __attribute__((address_space(1))) float gf32;
#define SC_SPIN_CAP (1u << 22)
__device__ __forceinline__ unsigned sc_ld(unsigned* p) { return __hip_atomic_load((gu32*)p, __ATOMIC_RELAXED, __HIP_MEMORY_SCOPE_AGENT); }
__device__ __forceinline__ void sc_st(unsigned* p, unsigned v) { __hip_atomic_store((gu32*)p, v, __ATOMIC_RELAXED, __HIP_MEMORY_SCOPE_AGENT); }
__device__ __forceinline__ float sc_ldf(float* p) { return __hip_atomic_load((gf32*)p, __ATOMIC_RELAXED, __HIP_MEMORY_SCOPE_AGENT); }
__device__ __forceinline__ void sc_stf(float* p, float v) { __hip_atomic_store((gf32*)p, v, __ATOMIC_RELAXED, __HIP_MEMORY_SCOPE_AGENT); }
__device__ __forceinline__ void sc_wait_ge(unsigned* p, unsigned v) { unsigned sp = 0; while (sc_ld(p) < v) { __builtin_amdgcn_s_sleep(2); if (++sp > SC_SPIN_CAP) break; } }
__device__ __forceinline__ float sigmoidf_(float x) { return 1.0f / (1.0f + __expf(-x)); }


#define LAS __attribute__((address_space(3)))
#define XB_TMO      128
#define XB_XCNT(j)  (256  + 64 * (j))
#define XB_XSUB(j)  (1280 + 64 * (j))
#define XB_XGEN(j)  (2304 + 64 * (j))
#define XB_TOP      3328
#define XB_TOPGEN   3392
#define XCD_BAR_WORDS 3456
#define XB_SPIN_CAP (1u << 18)
__device__ __forceinline__ unsigned xb_ld(unsigned* p)              { return __hip_atomic_load(p, __ATOMIC_RELAXED, __HIP_MEMORY_SCOPE_AGENT); }
__device__ __forceinline__ unsigned xb_add(unsigned* p, unsigned v) { return __hip_atomic_fetch_add(p, v, __ATOMIC_RELAXED, __HIP_MEMORY_SCOPE_AGENT); }
__device__ __forceinline__ unsigned xb_xcc_id() { return (unsigned)__builtin_amdgcn_s_getreg((3 << 11) | 20) & 0xFu; }
#define XB_SPIN(cond, bar) do { unsigned _sp = 0; while (cond) { __builtin_amdgcn_s_sleep(1); \
    if ((++_sp & 255u) == 0u) { if (xb_ld(&(bar)[XB_TMO])) break; if (_sp > XB_SPIN_CAP) { atomicAdd(&(bar)[XB_TMO], 1u); break; } } } } while (0)
struct XcdBarrier { unsigned* bar; unsigned x; volatile LAS unsigned* st; };
__device__ __forceinline__ XcdBarrier xcd_barrier_post(unsigned* bar, volatile LAS unsigned* st) {
    XcdBarrier b; b.bar = bar; b.x = xb_xcc_id(); b.st = st;
    if (threadIdx.x == 0) (void)xb_add(&bar[XB_XCNT(b.x)], 1u);
    return b;
}
__device__ __forceinline__ void xcd_barrier_complete(unsigned* bar, unsigned x, unsigned& nloc, unsigned& nx) {
    const unsigned G = gridDim.x * gridDim.y * gridDim.z;
    unsigned sum, cnt, mine, sp = 0u;
    for (;;) {
        sum = 0u; cnt = 0u; mine = 0u;
#pragma unroll
        for (unsigned j = 0; j < 16; ++j) { const unsigned c = xb_ld(&bar[XB_XCNT(j)]); sum += c; cnt += (c > 0u) ? 1u : 0u; mine = (j == x) ? c : mine; }
        if (sum == G) break;
        __builtin_amdgcn_s_sleep(1);
        if ((++sp & 255u) == 0u) { if (xb_ld(&bar[XB_TMO])) break; if (sp > XB_SPIN_CAP) { atomicAdd(&bar[XB_TMO], 1u); break; } }
    }
    nloc = mine > 0u ? mine : 1u; nx = cnt > 0u ? cnt : 1u;
}
__device__ __forceinline__ void xcd_barrier(const XcdBarrier& b) {
    asm volatile("s_waitcnt vmcnt(0)" ::: "memory");
    __syncthreads();
    if (threadIdx.x == 0) {
        unsigned* bar = b.bar;
        __builtin_amdgcn_s_waitcnt(0);
        unsigned nloc = b.st[0], nx = b.st[1];
        if (nloc == 0u) { xcd_barrier_complete(bar, b.x, nloc, nx); b.st[0] = nloc; b.st[1] = nx; }
        const unsigned old = xb_add(&bar[XB_XSUB(b.x)], 1u);
        const unsigned gen = old / nloc;
        if (old + 1u == (gen + 1u) * nloc) {
            __builtin_amdgcn_fence(__ATOMIC_RELEASE, "agent");
            asm volatile("s_waitcnt vmcnt(0)" ::: "memory");
            const unsigned og = xb_add(&bar[XB_TOP], 1u);
            const unsigned tg = og / nx;
            if (og + 1u == (tg + 1u) * nx) xb_add(&bar[XB_TOPGEN], 1u);
            else XB_SPIN(xb_ld(&bar[XB_TOPGEN]) == tg, bar);
            __builtin_amdgcn_fence(__ATOMIC_ACQUIRE, "agent");
            xb_add(&bar[XB_XGEN(b.x)], 1u);
            asm volatile("s_waitcnt vmcnt(0)" ::: "memory");
        } else {
            XB_SPIN(xb_ld(&bar[XB_XGEN(b.x)]) == gen, bar);
            __builtin_amdgcn_fence(__ATOMIC_ACQUIRE, "agent");
            asm volatile("s_waitcnt vmcnt(0)" ::: "memory");
        }
    }
    __syncthreads();
}

__device__ __forceinline__ int lds_byte(int r, int c) {
    int st = (r >> 4) * 2 + (c >> 5), rr = r & 15, cc = c & 31, ob = rr * 64 + cc * 2;
    return st * 1024 + (ob ^ (((ob >> 9) & 1) << 5));
}
__device__ __forceinline__ void stage_rc(int b, int& R, int& C) {
    int st = b / 1024, sb = b % 1024, swz = sb ^ (((sb >> 9) & 1) << 5);
    R = (st >> 1) * 16 + swz / 64; C = (st & 1) * 32 + (swz % 64) / 2;
}
__device__ __forceinline__ void unit_of(int L, int nM, int nN, int& pm, int& pn) {
    const int nwg = nM * nN; int wgid = L;
    { const int q = nwg / NXCD, r = nwg % NXCD, xcd = wgid % NXCD, off = wgid / NXCD; wgid = (xcd < r ? xcd * (q + 1) : r * (q + 1) + (xcd - r) * q) + off; }
    const int nig = WGM * nN, gid = wgid / nig, fm = gid * WGM, gsz = (nM - fm) < WGM ? (nM - fm) : WGM;
    pm = fm + ((wgid % nig) % gsz); pn = (wgid % nig) / gsz;
}

template <class Epi>
__device__ __forceinline__ void gemm_tile(const bf16_t* __restrict__ gA, const bf16_t* __restrict__ gB, const int K  , const int kbeg, const int nt  , const int pm, const int pn, const Epi& epi) {
    LAS unsigned char* lds = (LAS unsigned char*)smem_raw;
    constexpr int HTB = HT * 2;
    const int tid = threadIdx.x, wid = __builtin_amdgcn_readfirstlane(tid >> 6), lane = tid & 63, wr = wid >> 2, wc = wid & 3, fr = lane & 15, fq = lane >> 4;
    unsigned voff[2], voffB[2];
#pragma unroll
    for (int i = 0; i < 2; ++i) { int R, C; stage_rc(tid * 16 + i * 8192, R, C); voff[i] = (unsigned)(R * K + C) * 2u;
        const int rho = R & 31, Rb = (R & ~31) + 8 * ((rho & 15) >> 2) + 4 * (rho >> 4) + (rho & 3); voffB[i] = (unsigned)(Rb * K + C) * 2u; }
    const size_t kstep = (size_t)(BK * 2), hstep = (size_t)HALF * K * 2, tstep = 2 * hstep;
    const unsigned ldsw = (unsigned)wid * 1024u;
    const int aoff = lds_byte(wr * 64 + fr, fq * 8), boff = lds_byte(wc * 32 + fr, fq * 8);
    const char* cA = (const char*)gA + (size_t)pm * tstep + (size_t)kbeg * 2; const char* cB = (const char*)gB + (size_t)pn * tstep + (size_t)kbeg * 2;
#define SA(b, h) (((b) * 2 + (h)) * HTB)
#define SB(b, h) ((4 + (b) * 2 + (h)) * HTB)
#define STAGE(bufoff, gbase) do { _Pragma("unroll") for (int _i = 0; _i < 2; ++_i) \
    __builtin_amdgcn_global_load_lds((const unsigned*)((const char*)(gbase) + voff[_i]), (LAS unsigned*)(lds + (bufoff) + ldsw + _i * 8192), 16, 0, 0); } while (0)
#define STAGEB(bufoff, gbase) do { _Pragma("unroll") for (int _i = 0; _i < 2; ++_i) \
    __builtin_amdgcn_global_load_lds((const unsigned*)((const char*)(gbase) + voffB[_i]), (LAS unsigned*)(lds + (bufoff) + ldsw + _i * 8192), 16, 0, 0); } while (0)
#define LDA(dst, b, h) do { _Pragma("unroll") for (int m = 0; m < 4; ++m) _Pragma("unroll") for (int k = 0; k < 2; ++k) dst[m][k] = *(const LAS bf16x8*)(lds + SA(b, h) + aoff + m * 2048 + k * 1024); } while (0)
#define LDB(dst, b, h) do { _Pragma("unroll") for (int n = 0; n < 2; ++n) _Pragma("unroll") for (int k = 0; k < 2; ++k) dst[n][k] = *(const LAS bf16x8*)(lds + SB(b, h) + boff + n * 2048 + k * 1024); } while (0)
#define MMA(ai, bj, AT, BT) do { __builtin_amdgcn_s_setprio(1); _Pragma("unroll") for (int m = 0; m < 4; ++m) _Pragma("unroll") for (int n = 0; n < 2; ++n) _Pragma("unroll") for (int k = 0; k < 2; ++k) \
      acc[ai][bj][m][n] = __builtin_amdgcn_mfma_f32_16x16x32_bf16(BT[n][k], AT[m][k], acc[ai][bj][m][n], 0, 0, 0); \
    __builtin_amdgcn_s_setprio(0); } while (0)
#define WAIT_V(n) asm volatile("s_waitcnt vmcnt(" #n ")" ::: "memory")
#define WAIT_L(n) asm volatile("s_waitcnt lgkmcnt(" #n ")" ::: "memory")
#define BAR __builtin_amdgcn_s_barrier()
#define SCHED __builtin_amdgcn_sched_barrier(0)
    f32x4 acc[2][2][4][2];
#pragma unroll
    for (int a = 0; a < 2; ++a)
#pragma unroll
        for (int b = 0; b < 2; ++b)
#pragma unroll
            for (int m = 0; m < 4; ++m)
#pragma unroll
                for (int n = 0; n < 2; ++n) acc[a][b][m][n] = (f32x4){0.f, 0.f, 0.f, 0.f};
    bf16x8 At[4][2], B0[2][2], B1[2][2];
    STAGEB(SB(0, 0), cB); STAGE(SA(0, 0), cA); STAGEB(SB(0, 1), cB + hstep); STAGE(SA(0, 1), cA + hstep);
    if (wr == 1) BAR;
    WAIT_V(4); BAR;
    STAGEB(SB(1, 0), cB + kstep); STAGE(SA(1, 0), cA + kstep); STAGEB(SB(1, 1), cB + hstep + kstep);
    WAIT_V(6); BAR;
    for (int t = 0; t < nt - 2; t += 2) {
        const char* a1 = cA + (size_t)(t + 1) * kstep;
        const char* a2 = cA + (size_t)(t + 2) * kstep; const char* b2 = cB + (size_t)(t + 2) * kstep;
        const char* a3 = a2 + kstep; const char* b3 = b2 + kstep;
        LDB(B0, 0, 0); SCHED; LDA(At, 0, 0); STAGE(SA(1, 1), a1 + hstep);
        WAIT_L(8); BAR; WAIT_L(0); MMA(0, 0, At, B0); BAR; SCHED;
        LDB(B1, 0, 1); STAGEB(SB(0, 0), b2);
        BAR; WAIT_L(0); MMA(0, 1, At, B1); BAR;
        LDA(At, 0, 1); STAGE(SA(0, 0), a2);
        BAR; WAIT_L(0); MMA(1, 0, At, B0); BAR; SCHED;
        STAGEB(SB(0, 1), b2 + hstep);
        WAIT_V(6); BAR; MMA(1, 1, At, B1); BAR;
        LDB(B0, 1, 0); SCHED; LDA(At, 1, 0); STAGE(SA(0, 1), a2 + hstep);
        WAIT_L(8); BAR; WAIT_L(0); MMA(0, 0, At, B0); BAR; SCHED;
        LDB(B1, 1, 1); STAGEB(SB(1, 0), b3);
        BAR; WAIT_L(0); MMA(0, 1, At, B1); BAR;
        LDA(At, 1, 1); STAGE(SA(1, 0), a3);
        BAR; WAIT_L(0); MMA(1, 0, At, B0); BAR; SCHED;
        STAGEB(SB(1, 1), b3 + hstep);
        WAIT_V(6); BAR; MMA(1, 1, At, B1); BAR;
    }
    { const char* aL = cA + (size_t)(nt - 1) * kstep;
      LDB(B0, 0, 0); LDA(At, 0, 0); STAGE(SA(1, 1), aL + hstep);
      BAR; WAIT_L(0); MMA(0, 0, At, B0); BAR;
      LDB(B1, 0, 1); BAR; WAIT_L(0); MMA(0, 1, At, B1); BAR;
      LDA(At, 0, 1); WAIT_V(4); BAR; WAIT_L(0); MMA(1, 0, At, B0); MMA(1, 1, At, B1); BAR; }
    { LDB(B0, 1, 0); LDA(At, 1, 0); WAIT_V(2); BAR; WAIT_L(0); MMA(0, 0, At, B0); BAR;
      LDB(B1, 1, 1); WAIT_V(0); BAR; WAIT_L(0); MMA(0, 1, At, B1); BAR;
      LDA(At, 1, 1); BAR; WAIT_L(0); MMA(1, 0, At, B0); MMA(1, 1, At, B1); BAR; }
    if (wr == 0) BAR;
    if constexpr (Epi::FUSED) { __syncthreads(); epi.fused(acc, pm, pn, wr, wc, fr, fq); __syncthreads(); return; }
    const int brow = pm * BM;
#pragma unroll
    for (int ai = 0; ai < 2; ++ai)
#pragma unroll
        for (int m = 0; m < 4; ++m) {
#pragma unroll
            for (int bj = 0; bj < 2; ++bj)
                epi(acc[ai][bj][m][0], acc[ai][bj][m][1], brow + ai * HALF + wr * 64 + m * 16 + fr, bj * HALF + wc * 32 + fq * 8, pn);
            asm volatile("" ::: "memory");
        }
    __syncthreads();
#undef SA
#undef SB
#undef STAGE
#undef STAGEB
#undef LDA
#undef LDB
#undef MMA
}

struct Epi1 {
    static constexpr bool FUSED = false;
    unsigned char* ws; const float* lbp;
    __device__ __forceinline__ void operator()(const f32x4& v0, const f32x4& v1, int row, int cl, int pn) const {
        if (pn < 16) {
            const int sec = pn >> 2, c = (pn & 3) * 256 + cl;
            if (sec == 1) {
                f32x4 o0, o1;
                const f32x4 p00 = *(const f32x4*)(lbp + c), p01 = *(const f32x4*)(lbp + c + 4), p10 = *(const f32x4*)(lbp + 1024 + c), p11 = *(const f32x4*)(lbp + 1024 + c + 4);
#pragma unroll
                for (int j = 0; j < 4; ++j) { const float l0 = sigmoidf_(p00[j] - p10[j]), l1 = sigmoidf_(p01[j] - p11[j]);
                    o0[j] = l0 + (1.0f - l0) * sigmoidf_(v0[j]); o1[j] = l1 + (1.0f - l1) * sigmoidf_(v1[j]); }
                float* d = (float*)(ws + OFF_F) + (size_t)row * 1024 + c;
                *(f32x4*)d = o0; *(f32x4*)(d + 4) = o1;
            } else {
                bf16_t* dst = (bf16_t*)(ws + (sec == 0 ? OFF_Q : (sec == 2 ? OFF_I : OFF_GH))) + (size_t)row * 1024 + c;
                f32x4 o0 = v0, o1 = v1;
                if (sec == 3) {
#pragma unroll
                    for (int j = 0; j < 4; ++j) { o0[j] = v0[j] * sigmoidf_(v0[j]); o1[j] = v1[j] * sigmoidf_(v1[j]); }
                }
                uint4 w; w.x = pack2(o0[0], o0[1]); w.y = pack2(o0[2], o0[3]); w.z = pack2(o1[0], o1[1]); w.w = pack2(o1[2], o1[3]);
                *(uint4*)dst = w;
            }
        } else {
            bf16_t* dst = (bf16_t*)(ws + OFF_RKVG) + (size_t)row * 4096 + (pn - 16) * 256 + cl;
            uint4 w; w.x = pack2(v0[0], v0[1]); w.y = pack2(v0[2], v0[3]); w.z = pack2(v1[0], v1[1]); w.w = pack2(v1[2], v1[3]);
            *(uint4*)dst = w;
        }
    }
};
struct EpiPart {
    static constexpr bool FUSED = false;
    float* dst;
    __device__ __forceinline__ void operator()(const f32x4& v0, const f32x4& v1, int row, int cl, int pn) const {
        float* d = dst + (size_t)row * 256 + cl;
        *(f32x4*)d = v0; *(f32x4*)(d + 4) = v1;
    }
};
struct Epi2 {
    static constexpr bool FUSED = true;
    const float* x; float* out; const float* g; float* part; unsigned* cnt;
    __device__ __forceinline__ void fused(f32x4 (&acc)[2][2][4][2], int pm, int pn, int wr, int wc, int fr, int fq) const {
        LAS float* ssum = (LAS float*)smem_raw;
        LAS float* rsl = ssum + 1024;
        const int tid = threadIdx.x;
#pragma unroll
        for (int ai = 0; ai < 2; ++ai)
#pragma unroll
            for (int m = 0; m < 4; ++m) {
                const int r = ai * HALF + wr * 64 + m * 16 + fr; float s = 0.f;
#pragma unroll
                for (int bj = 0; bj < 2; ++bj)
#pragma unroll
                    for (int n = 0; n < 2; ++n) {
                        const f32x4 xv = *(const f32x4*)(x + (size_t)(pm * BM + r) * DM + pn * BM + bj * HALF + wc * 32 + fq * 8 + n * 4);
                        const f32x4 hv = acc[ai][bj][m][n] + xv; acc[ai][bj][m][n] = hv;
                        s += hv[0] * hv[0] + hv[1] * hv[1] + hv[2] * hv[2] + hv[3] * hv[3];
                    }
                s += __shfl_xor(s, 16); s += __shfl_xor(s, 32);
                if (fq == 0) ssum[r * 4 + wc] = s;
            }
        __syncthreads();
        if (tid < 256) sc_stf(part + (size_t)(pm * 8 + pn) * 256 + tid, (ssum[tid * 4] + ssum[tid * 4 + 1]) + (ssum[tid * 4 + 2] + ssum[tid * 4 + 3]));
        asm volatile("s_waitcnt vmcnt(0)" ::: "memory");
        __syncthreads();
        if (tid == 0) { __hip_atomic_fetch_add((gu32*)(cnt + pm * 16), 1u, __ATOMIC_RELAXED, __HIP_MEMORY_SCOPE_AGENT); sc_wait_ge(cnt + pm * 16, 8u); }
        __syncthreads();
        __builtin_amdgcn_fence(__ATOMIC_ACQUIRE, "agent");
        if (tid < 256) { float t = 0.f;
#pragma unroll
            for (int q = 0; q < 8; ++q) t += sc_ldf(part + (size_t)(pm * 8 + q) * 256 + tid);
            rsl[tid] = rsqrtf(t * (1.0f / DM) + 1e-6f); }
        __syncthreads();
#pragma unroll
        for (int ai = 0; ai < 2; ++ai)
#pragma unroll
            for (int m = 0; m < 4; ++m) {
                const int r = ai * HALF + wr * 64 + m * 16 + fr; const float rs = rsl[r];
#pragma unroll
                for (int bj = 0; bj < 2; ++bj)
#pragma unroll
                    for (int n = 0; n < 2; ++n) {
                        const int c = pn * BM + bj * HALF + wc * 32 + fq * 8 + n * 4;
                        const f32x4 gv = *(const f32x4*)(g + c);
                        *(f32x4*)(out + (size_t)(pm * BM + r) * DM + c) = acc[ai][bj][m][n] * rs * gv;
                    }
            }
    }
    __device__ __forceinline__ void operator()(const f32x4& v0, const f32x4& v1, int row, int cl, int pn) const {}
};
struct Epi3 {
    static constexpr bool FUSED = false;
    unsigned char* ws; const float* w0; const float* a0;
    __device__ __forceinline__ void operator()(const f32x4& v0, const f32x4& v1, int row, int cl, int pn) const {
        if (pn < 4) {
            const int c = pn * 256 + cl; const f32x4 b0 = *(const f32x4*)(w0 + c), b1 = *(const f32x4*)(w0 + c + 4); f32x4 o0, o1;
#pragma unroll
            for (int j = 0; j < 4; ++j) { o0[j] = __expf(-0.6065306597126334f * sigmoidf_(b0[j] + v0[j])); o1[j] = __expf(-0.6065306597126334f * sigmoidf_(b1[j] + v1[j])); }
            float* d = (float*)(ws + OFF_HN) + (size_t)row * 1024 + c;
            *(f32x4*)d = o0; *(f32x4*)(d + 4) = o1;
        } else {
            const int c = (pn - 4) * 256 + cl; const f32x4 b0 = *(const f32x4*)(a0 + c), b1 = *(const f32x4*)(a0 + c + 4);
            uint4 w; w.x = pack2(sigmoidf_(b0[0] + v0[0]), sigmoidf_(b0[1] + v0[1])); w.y = pack2(sigmoidf_(b0[2] + v0[2]), sigmoidf_(b0[3] + v0[3]));
            w.z = pack2(sigmoidf_(b1[0] + v1[0]), sigmoidf_(b1[1] + v1[1])); w.w = pack2(sigmoidf_(b1[2] + v1[2]), sigmoidf_(b1[3] + v1[3]));
            *(uint4*)((bf16_t*)(ws + OFF_WINT) + (size_t)row * 1024 + c) = w;
        }
    }
};

__device__ void build_lora_weights(const Params& p, int first, int stride) {
    bf16_t* lb = (bf16_t*)(p.ws + OFF_LB);
    for (int i = first; i < 2048 * 32; i += stride) {
        const int n = i >> 5, k0 = (i & 31) * 8; float e[8];
#pragma unroll
        for (int j = 0; j < 8; ++j) { const int k = k0 + j; float val = 0.f;
            if (n < 1024) { if (k < 96) val = p.w2[k * 1024 + n]; } else { if (k >= 128 && k < 224) val = p.a2[(k - 128) * 1024 + (n - 1024)]; }
            e[j] = val; }
        uint4 w; w.x = pack2(e[0], e[1]); w.y = pack2(e[2], e[3]); w.z = pack2(e[4], e[5]); w.w = pack2(e[6], e[7]);
        *(uint4*)(lb + (size_t)n * 256 + k0) = w;
    }
}
__device__ void prep_tiles(const Params& p, int t_begin, int t_end, int first, int stride) {
    const int tid = threadIdx.x;
    float* tile = (float*)smem_raw;
    bf16_t* wint = (bf16_t*)(p.ws + OFF_WINT);
    bf16_t* woutt = (bf16_t*)(p.ws + OFF_WOUTT);
    constexpr int NT1 = 132 * 32;
    const int lr = tid >> 4, lc = (tid & 15) * 4;
    f32x4 ld0, ld1; const f32x4 zero4 = {0.f, 0.f, 0.f, 0.f};
#define TR_DECODE(tl_) const float* src; int ld, c0; bf16_t* dst; int kt; \
        if ((tl_) < NT1) { const int ntile = (tl_) >> 5; kt = (tl_) & 31; const int n0 = ntile * 64; \
            c0 = n0 < 4096 ? 4288 + n0 : (n0 < 8192 ? n0 - 4096 : (n0 < 8384 ? 4096 + (n0 - 8192) : -1)); \
            src = p.w_in; ld = 8384; dst = wint + (size_t)n0 * DM; } \
        else { const int u = (tl_) - NT1; const int ntile = u >> 5; kt = u & 31; c0 = ntile * 64; src = p.w_out; ld = DM; dst = woutt + (size_t)ntile * 64 * DM; } \
        const int k0 = kt * 64;
#define TR_LOAD(tl_) do { TR_DECODE(tl_) (void)dst; \
        ld0 = c0 >= 0 ? *(const f32x4*)(src + (size_t)(k0 + lr) * ld + c0 + lc) : zero4; \
        ld1 = c0 >= 0 ? *(const f32x4*)(src + (size_t)(k0 + lr + 32) * ld + c0 + lc) : zero4; } while (0)
    if (t_begin + first < t_end) TR_LOAD(t_begin + first);
    for (int tl = t_begin + first; tl < t_end; tl += stride) {
        __syncthreads();
#pragma unroll
        for (int j = 0; j < 4; ++j) { tile[lr * 65 + lc + j] = ld0[j]; tile[(lr + 32) * 65 + lc + j] = ld1[j]; }
        __syncthreads();
        if (tl + stride < t_end) TR_LOAD(tl + stride);
        TR_DECODE(tl) (void)src; (void)ld; (void)c0;
        const int n = tid >> 3, ks = tid & 7;
        float e[8];
#pragma unroll
        for (int j = 0; j < 8; ++j) e[j] = tile[(ks * 8 + j) * 65 + n];
        uint4 w; w.x = pack2(e[0], e[1]); w.y = pack2(e[2], e[3]); w.z = pack2(e[4], e[5]); w.w = pack2(e[6], e[7]);
        *(uint4*)(dst + (size_t)n * DM + k0 + ks * 8) = w;
    }
#undef TR_LOAD
#undef TR_DECODE
    __syncthreads();
}

__device__ void phase_prep0(const Params& p) {
    const int tid = threadIdx.x, lane = tid & 63, wv = tid >> 6;
    const int gw = blockIdx.x * 8 + wv, nw = gridDim.x * 8;
    bf16_t* hn = (bf16_t*)(p.ws + OFF_HN);
    for (int row = gw; row < NTOK; row += nw) {
        const f32x4* xr = (const f32x4*)(p.x + (size_t)row * DM);
        f32x4 v[8]; float ss = 0.f;
#pragma unroll
        for (int i = 0; i < 8; ++i) { v[i] = xr[i * 64 + lane]; ss += v[i][0] * v[i][0] + v[i][1] * v[i][1] + v[i][2] * v[i][2] + v[i][3] * v[i][3]; }
        ss = wave_sum(ss);
        const float rs = rsqrtf(ss * (1.0f / DM) + 1e-6f);
#pragma unroll
        for (int i = 0; i < 8; ++i) {
            const f32x4 g = ((const f32x4*)p.norm_g)[i * 64 + lane];
            uint2 w; w.x = pack2(v[i][0] * rs * g[0], v[i][1] * rs * g[1]); w.y = pack2(v[i][2] * rs * g[2], v[i][3] * rs * g[3]);
            *(uint2*)(hn + (size_t)row * DM + (i * 64 + lane) * 4) = w;
        }
    }
    prep_tiles(p, 0, 132 * 32, blockIdx.x, gridDim.x);
}

__device__ void phase_gemm1(const Params& p) {
    const bf16_t* A = (const bf16_t*)(p.ws + OFF_HN);
    const bf16_t* B = (const bf16_t*)(p.ws + OFF_WINT);
    Epi1 epi{p.ws, p.lbp};
    for (int L = blockIdx.x; L < 32 * 32; L += gridDim.x) { int pm, pn; unit_of(L, 32, 32, pm, pn); gemm_tile(A, B, DM, 0, DM / BK, pm, pn, epi); }
    for (int it = blockIdx.x; it < 128; it += gridDim.x) { const int ks = it & 3; EpiPart ep{(float*)(p.ws + wp_off(ks))}; gemm_tile(A, B, DM, ks * 512, 8, it >> 2, 32, ep); }
    { const bool big = gridDim.x > 128; const int hb = big ? (int)blockIdx.x - 128 : (int)blockIdx.x, nh = big ? (int)gridDim.x - 128 : (int)gridDim.x;
      if (hb >= 0) { build_lora_weights(p, hb * 512 + threadIdx.x, nh * 512); prep_tiles(p, 132 * 32, 132 * 32 + 32 * 32, hb, nh); } }
}
__device__ void phase_gemm_lora(const Params& p) {
    const bf16_t* A = (const bf16_t*)(p.ws + OFF_LA);
    const bf16_t* B = (const bf16_t*)(p.ws + OFF_LB);
    Epi3 epi{p.ws, p.w0, p.a0};
    for (int L = blockIdx.x; L < 32 * 8; L += gridDim.x) { int pm, pn; unit_of(L, 32, 8, pm, pn); gemm_tile(A, B, 256, pn < 4 ? 0 : 128, 2, pm, pn, epi); }
}
__device__ void phase_gemm2(const Params& p) {
    const bf16_t* A = (const bf16_t*)(p.ws + OFF_F);
    const bf16_t* B = (const bf16_t*)(p.ws + OFF_WOUTT);
    Epi2 epi{p.x, p.out, p.final_g, (float*)(p.ws + OFF_WDAD), (unsigned*)(p.ws + OFF_FLG) + 48 * 64};
    for (int L = blockIdx.x; L < 32 * 8; L += gridDim.x) { int pm, pn; unit_of(L, 32, 8, pm, pn); gemm_tile(A, B, DM, 0, DM / BK, pm, pn, epi); }
}

__device__ __forceinline__ float tanh_fast(float x) { return 1.0f - 2.0f / (__expf(2.0f * x) + 1.0f); }
__device__ __forceinline__ float bflo(unsigned u) { return __uint_as_float(u << 16); }
__device__ __forceinline__ float bfhi(unsigned u) { return __uint_as_float(u & 0xffff0000u); }

__device__ void phase_lora_in(const Params& p) {
    const int tid = threadIdx.x, lane = tid & 63, wv = tid >> 6;
    const int gw = blockIdx.x * 8 + wv, nw = gridDim.x * 8;
    const bf16_t* rkvg = (const bf16_t*)(p.ws + OFF_RKVG);
    bf16_t* la = (bf16_t*)(p.ws + OFF_LA);
    float* inv = (float*)(p.ws + OFF_SC);
    const int o = 4 * lane, sidx = o < 128 ? o : o - 32; const bool valid = (o & 127) < 96;
    const f32x4 zero4 = {0.f, 0.f, 0.f, 0.f};
    const f32x4 mu4 = valid ? *(const f32x4*)(p.mu + 4096 + sidx) : zero4;
    float muk[16], ckk[16];
#pragma unroll
    for (int j = 0; j < 16; ++j) { muk[j] = p.mu[1024 + 16 * lane + j]; ckk[j] = p.k_k[16 * lane + j]; }
    for (int t0 = gw * 4; t0 < NTOK; t0 += nw * 4) {
        const bool first = (t0 & (TSEQ - 1)) == 0;
        f32x4 S[5]; u32x4 K0[5], K1[5];
#pragma unroll
        for (int r = 0; r < 5; ++r) {
            const int t = t0 + r - 1; const bool ok = r > 0 || !first;
            f32x4 s = zero4; u32x4 a0 = {0u, 0u, 0u, 0u}, a1 = a0;
            if (ok) {
                if (valid) {
#pragma unroll
                    for (int ks = 0; ks < 4; ++ks) s += *(const f32x4*)((const float*)(p.ws + wp_off(ks)) + (size_t)t * 256 + sidx);
                }
                a0 = *(const u32x4*)(rkvg + (size_t)t * 4096 + 1024 + 16 * lane); a1 = *(const u32x4*)(rkvg + (size_t)t * 4096 + 1024 + 16 * lane + 8);
            }
            S[r] = s; K0[r] = a0; K1[r] = a1;
        }
#pragma unroll
        for (int i = 0; i < 4; ++i) {
            const int t = t0 + i;
            f32x4 m = S[i + 1] + mu4 * (S[i] - S[i + 1]);
            if (o < 128) {
#pragma unroll
                for (int j = 0; j < 4; ++j) m[j] = tanh_fast(m[j]);
            }
            uint2 w; w.x = pack2(m[0], m[1]); w.y = pack2(m[2], m[3]);
            *(uint2*)(la + (size_t)t * 256 + o) = w;
            const unsigned kcw[8] = {K0[i + 1][0], K0[i + 1][1], K0[i + 1][2], K0[i + 1][3], K1[i + 1][0], K1[i + 1][1], K1[i + 1][2], K1[i + 1][3]};
            const unsigned kpw[8] = {K0[i][0], K0[i][1], K0[i][2], K0[i][3], K1[i][0], K1[i][1], K1[i][2], K1[i][3]};
            float ss = 0.f;
#pragma unroll
            for (int j = 0; j < 8; ++j) {
                const float c0 = bflo(kcw[j]), c1 = bfhi(kcw[j]), p0 = bflo(kpw[j]), p1 = bfhi(kpw[j]);
                const float k0 = (c0 + muk[2 * j] * (p0 - c0)) * ckk[2 * j], k1 = (c1 + muk[2 * j + 1] * (p1 - c1)) * ckk[2 * j + 1];
                ss += k0 * k0 + k1 * k1;
            }
            ss += dpp_f<0xB1>(ss); ss += dpp_f<0x4E>(ss);
            if ((lane & 3) == 0) inv[(size_t)t * 16 + (lane >> 2)] = 1.0f / fmaxf(sqrtf(ss), 1e-12f);
        }
    }
}

__device__ __forceinline__ void sc_publish_lds(unsigned char* g, int nbytes) {
    LAS unsigned char* lds = (LAS unsigned char*)smem_raw;
    const __amdgpu_buffer_rsrc_t rsrc = __builtin_amdgcn_make_buffer_rsrc(g, 0, nbytes, 0x00020000);
    for (int i = threadIdx.x * 16; i < nbytes; i += 512 * 16)
        __builtin_amdgcn_raw_buffer_store_b128(*(const LAS u32x4*)(lds + i), rsrc, (unsigned)i, 0,   16);
    asm volatile("s_waitcnt vmcnt(0)" ::: "memory");
}

__device__ __forceinline__ bf16x8 mk8(unsigned a, unsigned b, unsigned c, unsigned d) {
    union { unsigned u[4]; bf16x8 v; } x; x.u[0] = a; x.u[1] = b; x.u[2] = c; x.u[3] = d; return x.v;
}
typedef float f32x2_t __attribute__((ext_vector_type(2)));
typedef __bf16 bf16x2_t __attribute__((ext_vector_type(2)));
__device__ __forceinline__ unsigned cvt_pk_bf16(float lo, float hi) { const f32x2_t v = {lo, hi}; const bf16x2_t b = __builtin_convertvector(v, bf16x2_t); return __builtin_bit_cast(unsigned, b); }
#define ST_LO(ptr, u) (*(LAS bf16_t*)(ptr) = (bf16_t)((u) & 0xffffu))
#define ST_HI(ptr, u) (*(LAS bf16_t*)(ptr) = (bf16_t)((u) >> 16))
__device__ __forceinline__ int tile_off(int m, int fq, int row) { return m * 1024 + (fq * 16 + ((row + 4 * fq + m) & 15)) * 16; }
template <int PROD> __device__ void scan_hgrn_chunk(const Params& p, int bh, int pj) {
    LAS unsigned char* lds = (LAS unsigned char*)smem_raw;
    constexpr int SLOT = 13824, QF_O = 0, KF_O = 4096, AF_O = 8192, GC_O = 9216, VF_O = 9728, KT_BASE = 8 * SLOT;
    const int tid = threadIdx.x, lane = tid & 63, wv = tid >> 6, fr = lane & 15, fq = lane >> 4;
    const int b = bh >> 3, h = bh & 7;
    const size_t tb = (size_t)b * TSEQ;
    const bf16_t* Q = (const bf16_t*)(p.ws + OFF_Q) + h * 128;
    const float* F = (const float*)(p.ws + OFF_F) + h * 128;
    const bf16_t* I = (const bf16_t*)(p.ws + OFF_I) + h * 128 + wv * 16 + fr;
    const int vb = PROD == 2 ? pj * 4 + (wv & 3) : wv;
    bf16_t* YH = (bf16_t*)(p.ws + OFF_WINT) + (size_t)NTOK * 1024 + h * 128 + vb * 16 + fr;
    const bf16_t* Icol = (const bf16_t*)(p.ws + OFF_I) + h * 128;
    f32x4 Sacc[8];
#pragma unroll
    for (int i = 0; i < 8; ++i) Sacc[i] = (f32x4){0.f, 0.f, 0.f, 0.f};
    const int k0 = lane, k1 = lane + 64;
    const int qb0 = (k0 >> 5) * 1024 + ((k0 >> 2) & 3) * 256 + (((k0 >> 4) & 1) * 4 + (k0 & 3)) * 2, rot0 = 4 * ((k0 >> 2) & 3) + (k0 >> 5);
    const int qb1 = (k1 >> 5) * 1024 + ((k1 >> 2) & 3) * 256 + (((k1 >> 4) & 1) * 4 + (k1 & 3)) * 2, rot1 = 4 * ((k1 >> 2) & 3) + (k1 >> 5);
    int rdo[4];
#pragma unroll
    for (int m = 0; m < 4; ++m) rdo[m] = tile_off(m, fq, fr);
    const int ko0 = (((k0 >> 4) * 64 + (k0 & 15)) * 4) * 2, ko1 = (((k1 >> 4) * 64 + (k1 & 15)) * 4) * 2;
    unsigned short vcur[4], vnxt[4], raw_q0[16], raw_q1[16], raw_i0[16], raw_i1[16]; float raw_f0[16], raw_f1[16];
#define HG_PREFETCH(rnd) do { const size_t t0_ = tb + (size_t)((rnd) * 8 + wv) * 16; \
        _Pragma("unroll") for (int t_ = 0; t_ < 16; ++t_) { raw_q0[t_] = Q[(t0_ + t_) * 1024 + k0]; raw_q1[t_] = Q[(t0_ + t_) * 1024 + k1]; \
            raw_f0[t_] = F[(t0_ + t_) * 1024 + k0]; raw_f1[t_] = F[(t0_ + t_) * 1024 + k1]; \
            if (PROD == 1) { raw_i0[t_] = Icol[(t0_ + t_) * 1024 + k0]; raw_i1[t_] = Icol[(t0_ + t_) * 1024 + k1]; } } } while (0)
    unsigned* flg = (unsigned*)(p.ws + OFF_FLG) + (32 + bh) * 64;
    const unsigned char* ring = p.ws + OFF_RING_H + (size_t)bh * 4 * 8 * SLOT;
    constexpr int NCP = (4 * SLOT + 4095) / 4096;
    const bool stager = wv >= 4;
    u32x4 cp[NCP];
#define RING_LOADH(hr_) do { const unsigned char* s_ = ring + (size_t)((((hr_) >> 1) & 3) * 8 + ((hr_) & 1) * 4) * SLOT;     \
        _Pragma("unroll") for (int i_ = 0; i_ < NCP; ++i_) { int o_ = i_ * 4096 + (tid - 256) * 16; o_ = o_ < 4 * SLOT ? o_ : 4 * SLOT - 16; cp[i_] = *(const u32x4*)(s_ + o_); } } while (0)
#define CP_TO_LDS(hr_) do { LAS unsigned char* d_ = lds + ((hr_) & 1) * 4 * SLOT; \
        _Pragma("unroll") for (int i_ = 0; i_ < NCP; ++i_) { int o_ = i_ * 4096 + (tid - 256) * 16; o_ = o_ < 4 * SLOT ? o_ : 4 * SLOT - 16; *(LAS u32x4*)(d_ + o_) = cp[i_]; } } while (0)
    unsigned early = 0u;
    if (PROD == 2) { if (stager) { sc_wait_ge(flg + 0, 1u); __builtin_amdgcn_fence(__ATOMIC_ACQUIRE, "agent"); RING_LOADH(0); CP_TO_LDS(0); RING_LOADH(1); } }
    else HG_PREFETCH(PROD ? pj : 0);
    constexpr int NJ = PROD == 2 ? 4 : 8;
    for (int round = PROD == 1 ? pj : 0; round < (PROD == 2 ? TSEQ / 64 : TSEQ / 128); round += PROD == 1 ? 4 : 1) {
        __syncthreads();
        if (PROD == 0) {
#pragma unroll
            for (int jj = 0; jj < 4; ++jj) vcur[jj] = I[(tb + (size_t)(round * 8) * 16 + fq * 4 + jj) * 1024];
        }
        if (PROD == 2) {
            const int hr = round;
            if (stager) {
                if ((hr & 1) && tid == 256) sc_st(flg + 16 + pj, (unsigned)((hr >> 1) + 1));
                if (hr + 1 < TSEQ / 64) CP_TO_LDS(hr + 1);
                if (hr + 2 < TSEQ / 64) {
                    if (((hr + 2) & 1) == 0) { const int rn = (hr + 2) >> 1; if (early < (unsigned)(rn + 1)) sc_wait_ge(flg + (rn & 3), (unsigned)(rn + 1)); __builtin_amdgcn_fence(__ATOMIC_ACQUIRE, "agent"); }
                    RING_LOADH(hr + 2);
                    if (((hr + 2) & 1) == 0) early = sc_ld(flg + ((((hr + 2) >> 1) + 1) & 3));
                }
            }
        } else
        {
            LAS unsigned char* slot = lds + wv * SLOT; LAS unsigned char* kt = lds + KT_BASE + wv * 4096;
            float G0 = 1.f, G1 = 1.f;
            int rot0v = rot0, rot1v = rot1; asm volatile("" : "+v"(rot0v), "+v"(rot1v));
#pragma unroll
            for (int t = 0; t < 16; ++t) {
                const float q0 = bf2f(raw_q0[t]), q1 = bf2f(raw_q1[t]);
                const float f0 = raw_f0[t], f1 = raw_f1[t];
                G0 *= f0; G1 *= f1;
                const float r0 = __builtin_amdgcn_rcpf(G0), r1 = __builtin_amdgcn_rcpf(G1);
                const int qo0 = qb0 + (((t + rot0v) & 15) << 4), qo1 = qb1 + (((t + rot1v) & 15) << 4);
                const unsigned uq = cvt_pk_bf16(q0 * G0, q1 * G1), uk = cvt_pk_bf16((1.0f - f0) * r0, (1.0f - f1) * r1);
                ST_LO(slot + QF_O + qo0, uq); ST_HI(slot + QF_O + qo1, uq);
                ST_LO(kt + qo0, uk); ST_HI(kt + qo1, uk);
            }
            *(LAS float*)(slot + GC_O + k0 * 4) = G0; *(LAS float*)(slot + GC_O + k1 * 4) = G1;
            if (PROD == 1) {
#pragma unroll
                for (int s = 0; s < 16; s += 2) {
                    *(LAS unsigned*)(slot + VF_O + (((k0 >> 4) * 64 + (s >> 2) * 16 + (k0 & 15)) * 4 + (s & 3)) * 2) = (unsigned)raw_i0[s] | ((unsigned)raw_i0[s + 1] << 16);
                    *(LAS unsigned*)(slot + VF_O + (((k1 >> 4) * 64 + (s >> 2) * 16 + (k1 & 15)) * 4 + (s & 3)) * 2) = (unsigned)raw_i1[s] | ((unsigned)raw_i1[s + 1] << 16);
                }
            }
            int rot0w = rot0, rot1w = rot1; asm volatile("" : "+v"(rot0w), "+v"(rot1w));
#pragma unroll
            for (int s = 0; s < 16; ++s) {
                const float ka = bf2f(*(const LAS bf16_t*)(kt + qb0 + (((s + rot0w) & 15) << 4))), kb_ = bf2f(*(const LAS bf16_t*)(kt + qb1 + (((s + rot1w) & 15) << 4)));
                const unsigned u = cvt_pk_bf16(ka * G0, kb_ * G1);
                ST_LO(slot + KF_O + ko0 + ((s >> 2) * 16 * 4 + (s & 3)) * 2, u);
                ST_HI(slot + KF_O + ko1 + ((s >> 2) * 16 * 4 + (s & 3)) * 2, u);
            }
            *(LAS u32x2*)(slot + AF_O + lane * 16 + 8) = (u32x2){0u, 0u};
            asm volatile("s_waitcnt lgkmcnt(0)" ::: "memory");
            f32x4 d = {0.f, 0.f, 0.f, 0.f};
#pragma unroll
            for (int m = 0; m < 4; ++m) {
                const bf16x8 a = *(const LAS bf16x8*)(slot + QF_O + rdo[m]), bb = *(const LAS bf16x8*)(kt + rdo[m]);
                d = __builtin_amdgcn_mfma_f32_16x16x32_bf16(a, bb, d, 0, 0, 0);
            }
#pragma unroll
            for (int r = 0; r < 4; ++r) { const int t = fq * 4 + r, s = fr;
                const unsigned u = cvt_pk_bf16(s <= t ? d[r] : 0.f, 0.f);
                ST_LO(slot + AF_O + (((s >> 2) * 16 + t) * 8 + (s & 3)) * 2, u); }
        }
        if (PROD != 2) __syncthreads();
        if (PROD == 2) {
        } else if (PROD == 1) {
            if (round + 4 < TSEQ / 128) HG_PREFETCH(round + 4);
            if (round >= 4) { if (tid < 2) sc_wait_ge(flg + 16 + tid, (unsigned)(round - 3)); __syncthreads(); }
            sc_publish_lds(p.ws + OFF_RING_H + ((size_t)bh * 4 + pj) * 8 * SLOT, 8 * SLOT);
            __syncthreads();
            if (tid == 0) sc_st(flg + pj, (unsigned)(round + 1));
            continue;
        } else if (round + 1 < TSEQ / 128) HG_PREFETCH(round + 1);
        if (PROD == 2 && !stager) {
            bf16x8 fa[5]; u32x2 fk[8], fv; f32x4 fg[8];
#define WLDG(j_) do { LAS unsigned char* s_ = lds + ((round & 1) * 4 + (j_)) * SLOT; \
                _Pragma("unroll") for (int kb_ = 0; kb_ < 8; ++kb_) fg[kb_] = *(const LAS f32x4*)(s_ + GC_O + (kb_ * 16 + fq * 4) * 4); } while (0)
#define WLDH(A_, K_, V_, j_) do { LAS unsigned char* s_ = lds + ((round & 1) * 4 + (j_)) * SLOT; \
                _Pragma("unroll") for (int m_ = 0; m_ < 4; ++m_) A_[m_] = *(const LAS bf16x8*)(s_ + QF_O + rdo[m_]); \
                A_[4] = *(const LAS bf16x8*)(s_ + AF_O + lane * 16); \
                _Pragma("unroll") for (int kb_ = 0; kb_ < 8; ++kb_) K_[kb_] = *(const LAS u32x2*)(s_ + KF_O + (kb_ * 64 + lane) * 8); \
                V_ = *(const LAS u32x2*)(s_ + VF_O + (vb * 64 + lane) * 8); } while (0)
            WLDH(fa, fk, fv, 0); WLDG(0);
#pragma unroll
            for (int j = 0; j < NJ; ++j) {
                bf16x8 na[5]; u32x2 nk[8], nv;
                if (j + 1 < NJ) WLDH(na, nk, nv, j + 1);
                const bf16x8 Vb = mk8(fv.x, fv.y, 0u, 0u);
                f32x4 o = {0.f, 0.f, 0.f, 0.f};
#pragma unroll
                for (int m = 0; m < 4; ++m) {
                    const bf16x8 sb = mk8(cvt_pk_bf16(Sacc[2 * m][0], Sacc[2 * m][1]), cvt_pk_bf16(Sacc[2 * m][2], Sacc[2 * m][3]), cvt_pk_bf16(Sacc[2 * m + 1][0], Sacc[2 * m + 1][1]), cvt_pk_bf16(Sacc[2 * m + 1][2], Sacc[2 * m + 1][3]));
                    o = __builtin_amdgcn_mfma_f32_16x16x32_bf16(fa[m], sb, o, 0, 0, 0);
                }
                o = __builtin_amdgcn_mfma_f32_16x16x32_bf16(fa[4], Vb, o, 0, 0, 0);
#pragma unroll
                for (int kb = 0; kb < 8; ++kb) Sacc[kb] = __builtin_amdgcn_mfma_f32_16x16x32_bf16(mk8(fk[kb].x, fk[kb].y, 0u, 0u), Vb, Sacc[kb] * fg[kb], 0, 0, 0);
                if (j + 1 < NJ) WLDG(j + 1);
                { bf16_t* yo = YH + (tb + (size_t)(round * NJ + j) * 16 + fq * 4) * 1024;
                  const unsigned y01 = cvt_pk_bf16(o[0], o[1]), y23 = cvt_pk_bf16(o[2], o[3]);
                  yo[0] = (bf16_t)(y01 & 0xffffu); yo[1024] = (bf16_t)(y01 >> 16); yo[2048] = (bf16_t)(y23 & 0xffffu); yo[3072] = (bf16_t)(y23 >> 16); }
                if (j + 1 < NJ) {
#pragma unroll
                    for (int i = 0; i < 5; ++i) fa[i] = na[i];
#pragma unroll
                    for (int i = 0; i < 8; ++i) fk[i] = nk[i];
                    fv = nv;
                }
            }
#undef WLDH
#undef WLDG
        }
    }
    __syncthreads();
}


template <int PROD> __device__ void scan_rwkv_chunk(const Params& p, int bh, int pj) {
    LAS unsigned char* lds = (LAS unsigned char*)smem_raw;
    constexpr int SLOT = 12544, WA_O = 0, RT_O = 2048, MAK_O = 4096, RBK_O = 5120, KB_O = 6144, GC_O = 10240, VF_O = 10496, TMP_BASE = 8 * SLOT, TMP = 6144;
    const int tid = threadIdx.x, lane = tid & 63, wv = tid >> 6, fr = lane & 15, fq = lane >> 4;
    const int b = bh >> 4, h = bh & 15;
    const size_t tb = (size_t)b * TSEQ;
    const bf16_t* rkvg = (const bf16_t*)(p.ws + OFF_RKVG);
    const float* Wd = (const float*)(p.ws + OFF_HN);
    const bf16_t* As = (const bf16_t*)(p.ws + OFF_WINT);
    const float* invp = (const float*)(p.ws + OFF_SC);
    bf16_t* YR = (bf16_t*)(p.ws + OFF_YR) + h * 64 + wv * 16 + fr;
    const int col = h * 64 + lane;
    const float mur = p.mu[col], muk = p.mu[1024 + col], muv = p.mu[2048 + col], ckk = p.k_k[col], cka = p.k_a[col];
    const int qb = (lane >> 5) * 1024 + ((lane >> 2) & 3) * 256 + (((lane >> 4) & 1) * 4 + (lane & 3)) * 2, rot = 4 * ((lane >> 2) & 3) + (lane >> 5);
    const int rd0 = tile_off(0, fq, fr), rd1 = tile_off(1, fq, fr);
    const int kbo = KB_O + (lane >> 4) * 1024 + (lane & 15) * 16;
    const int vfo = VF_O + (((lane >> 4) * 64 + (lane & 15)) * 4) * 2;
    f32x4 Sacc[4];
#pragma unroll
    for (int i = 0; i < 4; ++i) Sacc[i] = (f32x4){0.f, 0.f, 0.f, 0.f};
    unsigned short raw_r[16], raw_k[16], raw_v[16], raw_a[16], raw_rp, raw_kp, raw_vp; float raw_w[16], raw_i[16];
#define RW_PREFETCH(rnd) do { const int c_ = (rnd) * 8 + wv; const size_t t0_ = tb + (size_t)c_ * 16; \
        raw_rp = 0; raw_kp = 0; raw_vp = 0; \
        if (c_ > 0) { const bf16_t* pr_ = rkvg + (t0_ - 1) * 4096 + col; raw_rp = pr_[0]; raw_kp = pr_[1024]; raw_vp = pr_[2048]; } \
        _Pragma("unroll") for (int t_ = 0; t_ < 16; ++t_) { const bf16_t* pr_ = rkvg + (t0_ + t_) * 4096 + col; \
            raw_r[t_] = pr_[0]; raw_k[t_] = pr_[1024]; raw_v[t_] = pr_[2048]; \
            raw_w[t_] = Wd[(t0_ + t_) * 1024 + col]; raw_a[t_] = As[(t0_ + t_) * 1024 + col]; raw_i[t_] = invp[(t0_ + t_) * 16 + h]; } } while (0)
    unsigned* flg = (unsigned*)(p.ws + OFF_FLG) + bh * 64;
    const unsigned char* ring = p.ws + OFF_RING_R + (size_t)bh * 4 * 8 * SLOT;
    constexpr int NCP = (4 * SLOT + 4095) / 4096;
    const bool stager = wv >= 4;
    u32x4 cp[NCP];
#define RING_LOAD(hr_) do { const unsigned char* s_ = ring + (size_t)((((hr_) >> 1) & 3) * 8 + ((hr_) & 1) * 4) * SLOT;     \
        _Pragma("unroll") for (int i_ = 0; i_ < NCP; ++i_) { int o_ = i_ * 4096 + (tid - 256) * 16; o_ = o_ < 4 * SLOT ? o_ : 4 * SLOT - 16; cp[i_] = *(const u32x4*)(s_ + o_); } } while (0)
#define CP_TO_LDS(hr_) do { LAS unsigned char* d_ = lds + ((hr_) & 1) * 4 * SLOT; \
        _Pragma("unroll") for (int i_ = 0; i_ < NCP; ++i_) { int o_ = i_ * 4096 + (tid - 256) * 16; o_ = o_ < 4 * SLOT ? o_ : 4 * SLOT - 16; *(LAS u32x4*)(d_ + o_) = cp[i_]; } } while (0)
    unsigned early = 0u;
    if (PROD == 2) { if (stager) { sc_wait_ge(flg + 0, 1u); __builtin_amdgcn_fence(__ATOMIC_ACQUIRE, "agent"); RING_LOAD(0); CP_TO_LDS(0); RING_LOAD(1); } }
    else RW_PREFETCH(PROD ? pj : 0);
    constexpr int NJ = PROD == 2 ? 4 : 8;
    for (int round = PROD == 1 ? pj : 0; round < (PROD == 2 ? TSEQ / 64 : TSEQ / 128); round += PROD == 1 ? 4 : 1) {
        __syncthreads();
        if (PROD == 2) {
            const int hr = round;
            if (stager) {
                if ((hr & 1) && tid == 256) sc_st(flg + 16, (unsigned)((hr >> 1) + 1));
                if (hr + 1 < TSEQ / 64) CP_TO_LDS(hr + 1);
                if (hr + 2 < TSEQ / 64) {
                    if (((hr + 2) & 1) == 0) { const int rn = (hr + 2) >> 1; if (early < (unsigned)(rn + 1)) sc_wait_ge(flg + (rn & 3), (unsigned)(rn + 1)); __builtin_amdgcn_fence(__ATOMIC_ACQUIRE, "agent"); }
                    RING_LOAD(hr + 2);
                    if (((hr + 2) & 1) == 0) early = sc_ld(flg + ((((hr + 2) >> 1) + 1) & 3));
                }
            }
        } else
        {
            LAS unsigned char* slot = lds + wv * SLOT; LAS unsigned char* tmp = lds + TMP_BASE + wv * TMP;
            float rp = bf2f(raw_rp), kp = bf2f(raw_kp), vp = bf2f(raw_vp);
            float G = 1.f, at[16], bt[16], kt[16];
            int rotv = rot; asm volatile("" : "+v"(rotv));
#pragma unroll
            for (int t = 0; t < 16; ++t) {
                const float rc = bf2f(raw_r[t]), kc = bf2f(raw_k[t]), vc = bf2f(raw_v[t]);
                const float w = raw_w[t], as = bf2f(raw_a[t]), iv = raw_i[t];
                const float r = rc + mur * (rp - rc), kx = kc + muk * (kp - kc), vm = vc + muv * (vp - vc);
                rp = rc; kp = kc; vp = vc;
                const float kkn = kx * ckk * iv, bb = kkn * as, k2 = kx * (1.0f + (as - 1.0f) * cka);
                const float Gp = G; G *= w; const float rG = __builtin_amdgcn_rcpf(G);
                const int qo = qb + (((t + rotv) & 15) << 4);
                at[t] = -kkn * Gp; bt[t] = bb * rG; kt[t] = k2 * rG;
                const unsigned u0 = cvt_pk_bf16(at[t], bt[t]), u1 = cvt_pk_bf16(kt[t], r * G), u2 = cvt_pk_bf16(vm, vm);
                ST_LO(tmp + qo, u0); ST_HI(tmp + 2048 + qo, u0);
                ST_LO(tmp + 4096 + qo, u1); ST_HI(slot + RT_O + qo, u1);
                ST_LO(slot + vfo + (t >> 2) * 128 + (t & 3) * 2, u2);
            }
            *(LAS float*)(slot + GC_O + lane * 4) = G;
#pragma unroll
            for (int s = 0; s < 16; ++s) {
                const unsigned u = cvt_pk_bf16(bt[s] * G, kt[s] * G);
                ST_LO(slot + kbo + (s >> 2) * 256 + (s & 3) * 2, u);
                ST_HI(slot + kbo + (s >> 2) * 256 + 8 + (s & 3) * 2, u);
            }
            *(LAS u32x2*)(slot + MAK_O + lane * 16) = (u32x2){0u, 0u};
            asm volatile("s_waitcnt lgkmcnt(0)" ::: "memory");
            f32x4 dab = {0.f, 0.f, 0.f, 0.f}, dak = dab, drb = dab, drk = dab;
#pragma unroll
            for (int m = 0; m < 2; ++m) {
                const int rd = m ? rd1 : rd0;
                const bf16x8 aA = *(const LAS bf16x8*)(tmp + rd), aR = *(const LAS bf16x8*)(slot + RT_O + rd);
                const bf16x8 bB = *(const LAS bf16x8*)(tmp + 2048 + rd), bK = *(const LAS bf16x8*)(tmp + 4096 + rd);
                dab = __builtin_amdgcn_mfma_f32_16x16x32_bf16(aA, bB, dab, 0, 0, 0);
                dak = __builtin_amdgcn_mfma_f32_16x16x32_bf16(aA, bK, dak, 0, 0, 0);
                drb = __builtin_amdgcn_mfma_f32_16x16x32_bf16(aR, bB, drb, 0, 0, 0);
                drk = __builtin_amdgcn_mfma_f32_16x16x32_bf16(aR, bK, drk, 0, 0, 0);
            }
            asm volatile("s_waitcnt lgkmcnt(0)" ::: "memory");
#pragma unroll
            for (int r = 0; r < 4; ++r) { const int t = fq * 4 + r, s = fr;
                *(LAS float*)(tmp + (t * 16 + s) * 4) = s < t ? dab[r] : 0.f;
                *(LAS float*)(tmp + 1024 + (t * 16 + s) * 4) = s < t ? dak[r] : 0.f;
                LAS unsigned char* rb = slot + RBK_O + (((s >> 2) * 16 + t) * 8 + (s & 3)) * 2;
                const unsigned u = cvt_pk_bf16(s <= t ? drb[r] : 0.f, s <= t ? drk[r] : 0.f);
                ST_LO(rb, u); ST_HI(rb + 8, u); }
            asm volatile("s_waitcnt lgkmcnt(0)" ::: "memory");
            float Wc[16], Mc[16];
            int rotv4 = rot; asm volatile("" : "+v"(rotv4));
#pragma unroll
            for (int t = 0; t < 16; ++t) {
                float aw = at[t], am = *(const LAS float*)(tmp + 1024 + (t * 16 + fr) * 4);
#pragma unroll
                for (int s4 = 0; s4 < (t + 3) / 4; ++s4) {
                    const f32x4 row = *(const LAS f32x4*)(tmp + (t * 16 + s4 * 4) * 4);
#pragma unroll
                    for (int e = 0; e < 4; ++e) if (s4 * 4 + e < t) { aw += row[e] * Wc[s4 * 4 + e]; am += row[e] * Mc[s4 * 4 + e]; }
                }
                Wc[t] = aw; Mc[t] = am;
                { const unsigned u = cvt_pk_bf16(aw, am);
                  ST_LO(slot + WA_O + qb + (((t + rotv4) & 15) << 4), u);
                  if (lane < 16) ST_HI(slot + MAK_O + (((lane >> 2) * 16 + t) * 8 + 4 + (lane & 3)) * 2, u); }
            }
        }
        if (PROD != 2) __syncthreads();
        if (PROD == 2) {
        } else if (PROD == 1) {
            if (round + 4 < TSEQ / 128) RW_PREFETCH(round + 4);
            if (round >= 4) { if (tid == 0) sc_wait_ge(flg + 16, (unsigned)(round - 3)); __syncthreads(); }
            sc_publish_lds(p.ws + OFF_RING_R + ((size_t)bh * 4 + pj) * 8 * SLOT, 8 * SLOT);
            __syncthreads();
            if (tid == 0) sc_st(flg + pj, (unsigned)(round + 1));
            continue;
        } else if (round + 1 < TSEQ / 128) RW_PREFETCH(round + 1);
        if (wv < 4) {
            bf16x8 fa[10]; f32x4 fg[4]; u32x2 fv;
#define WLD(A_, G_, V_, j_) do { LAS unsigned char* s_ = lds + (PROD == 2 ? (round & 1) * 4 + (j_) : (j_)) * SLOT; \
                A_[0] = *(const LAS bf16x8*)(s_ + WA_O + rd0); A_[1] = *(const LAS bf16x8*)(s_ + WA_O + rd1); A_[2] = *(const LAS bf16x8*)(s_ + RT_O + rd0); A_[3] = *(const LAS bf16x8*)(s_ + RT_O + rd1); \
                A_[4] = *(const LAS bf16x8*)(s_ + MAK_O + lane * 16); A_[5] = *(const LAS bf16x8*)(s_ + RBK_O + lane * 16); \
                _Pragma("unroll") for (int kb_ = 0; kb_ < 4; ++kb_) { A_[6 + kb_] = *(const LAS bf16x8*)(s_ + KB_O + kb_ * 1024 + lane * 16); G_[kb_] = *(const LAS f32x4*)(s_ + GC_O + (kb_ * 16 + fq * 4) * 4); } \
                V_ = *(const LAS u32x2*)(s_ + VF_O + (wv * 64 + lane) * 8); } while (0)
            WLD(fa, fg, fv, 0);
#pragma unroll
            for (int j = 0; j < NJ; ++j) {
                bf16x8 na[10]; f32x4 ng[4]; u32x2 nv;
                if (j + 1 < NJ) WLD(na, ng, nv, j + 1);
                const bf16x8 sb0 = mk8(cvt_pk_bf16(Sacc[0][0], Sacc[0][1]), cvt_pk_bf16(Sacc[0][2], Sacc[0][3]), cvt_pk_bf16(Sacc[1][0], Sacc[1][1]), cvt_pk_bf16(Sacc[1][2], Sacc[1][3]));
                const bf16x8 sb1 = mk8(cvt_pk_bf16(Sacc[2][0], Sacc[2][1]), cvt_pk_bf16(Sacc[2][2], Sacc[2][3]), cvt_pk_bf16(Sacc[3][0], Sacc[3][1]), cvt_pk_bf16(Sacc[3][2], Sacc[3][3]));
                f32x4 u = {0.f, 0.f, 0.f, 0.f}, y = u;
                u = __builtin_amdgcn_mfma_f32_16x16x32_bf16(fa[0], sb0, u, 0, 0, 0);
                u = __builtin_amdgcn_mfma_f32_16x16x32_bf16(fa[1], sb1, u, 0, 0, 0);
                u = __builtin_amdgcn_mfma_f32_16x16x32_bf16(fa[4], mk8(0u, 0u, fv.x, fv.y), u, 0, 0, 0);
                y = __builtin_amdgcn_mfma_f32_16x16x32_bf16(fa[2], sb0, y, 0, 0, 0);
                y = __builtin_amdgcn_mfma_f32_16x16x32_bf16(fa[3], sb1, y, 0, 0, 0);
                const bf16x8 uv = mk8(cvt_pk_bf16(u[0], u[1]), cvt_pk_bf16(u[2], u[3]), fv.x, fv.y);
                y = __builtin_amdgcn_mfma_f32_16x16x32_bf16(fa[5], uv, y, 0, 0, 0);
#pragma unroll
                for (int kb = 0; kb < 4; ++kb) Sacc[kb] = __builtin_amdgcn_mfma_f32_16x16x32_bf16(fa[6 + kb], uv, Sacc[kb] * fg[kb], 0, 0, 0);
                { bf16_t* yo = YR + (tb + (size_t)(round * NJ + j) * 16 + fq * 4) * 1024;
                  const unsigned y01 = cvt_pk_bf16(y[0], y[1]), y23 = cvt_pk_bf16(y[2], y[3]);
                  yo[0] = (bf16_t)(y01 & 0xffffu); yo[1024] = (bf16_t)(y01 >> 16); yo[2048] = (bf16_t)(y23 & 0xffffu); yo[3072] = (bf16_t)(y23 >> 16); }
                if (j + 1 < NJ) {
#pragma unroll
                    for (int i = 0; i < 10; ++i) fa[i] = na[i];
#pragma unroll
                    for (int i = 0; i < 4; ++i) fg[i] = ng[i];
                    fv = nv;
                }
            }
#undef WLD
        }
    }
    __syncthreads();
}


__device__ void phase_scan(const Params& p) {
    if (gridDim.x >= 256) {
        const int bi = blockIdx.x;
        if (bi < 32) scan_rwkv_chunk<2>(p, bi, 0);
        else if (bi < 64) scan_hgrn_chunk<2>(p, (bi - 32) >> 1, (bi - 32) & 1);
        else if (bi < 192) scan_rwkv_chunk<1>(p, (bi - 64) >> 2, (bi - 64) & 3);
        else scan_hgrn_chunk<1>(p, (bi - 192) >> 2, (bi - 192) & 3);
    }
    __syncthreads();
}

__device__ __forceinline__ void unpack8(const u32x4 u, float (&f)[8]) {
    f[0] = bflo(u[0]); f[1] = bfhi(u[0]); f[2] = bflo(u[1]); f[3] = bfhi(u[1]); f[4] = bflo(u[2]); f[5] = bfhi(u[2]); f[6] = bflo(u[3]); f[7] = bfhi(u[3]);
}
__device__ void phase_post(const Params& p) {
    const int tid = threadIdx.x, lane = tid & 63, wv = tid >> 6;
    const bf16_t* rkvg = (const bf16_t*)(p.ws + OFF_RKVG);
    const bf16_t* YR = (const bf16_t*)(p.ws + OFF_YR);
    const bf16_t* As = (const bf16_t*)(p.ws + OFF_WINT);
    const bf16_t* YH = (const bf16_t*)(p.ws + OFF_WINT) + (size_t)NTOK * 1024;
    const bf16_t* GH = (const bf16_t*)(p.ws + OFF_GH);
    bf16_t* Y = (bf16_t*)(p.ws + OFF_F);
    for (int gw = blockIdx.x * 8 + wv; gw < 2048; gw += gridDim.x * 8) {
        const int half = gw & 1, t0 = (gw >> 1) * 8;
        {
            const int c0 = half * 512 + lane * 8;
            float mur[8], muk[8], muv[8], mug[8], cka[8], crk[8], lw[8], lb[8];
#pragma unroll
            for (int j = 0; j < 8; ++j) { mur[j] = p.mu[c0 + j]; muk[j] = p.mu[1024 + c0 + j]; muv[j] = p.mu[2048 + c0 + j]; mug[j] = p.mu[3072 + c0 + j];
                cka[j] = p.k_a[c0 + j]; crk[j] = p.r_k[c0 + j]; lw[j] = p.lnx_w[c0 + j]; lb[j] = p.lnx_b[c0 + j]; }
            const u32x4 zero4 = {0u, 0u, 0u, 0u};
            u32x4 pr = zero4, pk = zero4, pv = zero4, pg = zero4;
            if (t0 & (TSEQ - 1)) { const bf16_t* q = rkvg + (size_t)(t0 - 1) * 4096 + c0; pr = *(const u32x4*)q; pk = *(const u32x4*)(q + 1024); pv = *(const u32x4*)(q + 2048); pg = *(const u32x4*)(q + 3072); }
#pragma unroll 1
            for (int tb4 = 0; tb4 < 8; tb4 += 2) {
                u32x4 ly[2], lr[2], lk[2], lv[2], lg[2], la[2];
#pragma unroll
                for (int i = 0; i < 2; ++i) { const size_t t = t0 + tb4 + i; const bf16_t* q = rkvg + t * 4096 + c0;
                    ly[i] = *(const u32x4*)(YR + t * 1024 + c0); lr[i] = *(const u32x4*)q; lk[i] = *(const u32x4*)(q + 1024); lv[i] = *(const u32x4*)(q + 2048); lg[i] = *(const u32x4*)(q + 3072);
                    la[i] = *(const u32x4*)(As + t * 1024 + c0); }
#pragma unroll
                for (int i = 0; i < 2; ++i) { const size_t t = t0 + tb4 + i;
                    float y[8], rc[8], kc[8], vc[8], gc[8], as[8], rp[8], kp[8], vp[8], gp[8];
                    unpack8(ly[i], y); unpack8(lr[i], rc); unpack8(lk[i], kc); unpack8(lv[i], vc); unpack8(lg[i], gc); unpack8(la[i], as);
                    unpack8(pr, rp); unpack8(pk, kp); unpack8(pv, vp); unpack8(pg, gp);
                    pr = lr[i]; pk = lk[i]; pv = lv[i]; pg = lg[i];
                    float s = ((y[0] + y[1]) + (y[2] + y[3])) + ((y[4] + y[5]) + (y[6] + y[7]));
                    s += dpp_f<0xB1>(s); s += dpp_f<0x4E>(s); s += dpp_f<0x141>(s);
                    const float mean = s * (1.0f / 64.0f);
                    float q2 = 0.f, bp = 0.f, v[8], gt[8];
#pragma unroll
                    for (int j = 0; j < 8; ++j) { y[j] -= mean; q2 += y[j] * y[j];
                        const float r = rc[j] + mur[j] * (rp[j] - rc[j]), k = kc[j] + muk[j] * (kp[j] - kc[j]);
                        v[j] = vc[j] + muv[j] * (vp[j] - vc[j]); gt[j] = gc[j] + mug[j] * (gp[j] - gc[j]);
                        bp += r * (k * (1.0f + (as[j] - 1.0f) * cka[j])) * crk[j]; }
                    q2 += dpp_f<0xB1>(q2); q2 += dpp_f<0x4E>(q2); q2 += dpp_f<0x141>(q2);
                    bp += dpp_f<0xB1>(bp); bp += dpp_f<0x4E>(bp); bp += dpp_f<0x141>(bp);
                    const float rs = rsqrtf(q2 * (1.0f / 64.0f) + 64e-5f);
                    float o[8];
#pragma unroll
                    for (int j = 0; j < 8; ++j) o[j] = (y[j] * rs * lw[j] + lb[j] + bp * v[j]) * gt[j] * sigmoidf_(gt[j]);
                    const u32x4 w = {cvt_pk_bf16(o[0], o[1]), cvt_pk_bf16(o[2], o[3]), cvt_pk_bf16(o[4], o[5]), cvt_pk_bf16(o[6], o[7])};
                    *(u32x4*)(Y + t * DM + c0) = w;
                }
            }
        }
        {
            const int c0 = half * 512 + lane * 8;
            float hg[8];
#pragma unroll
            for (int j = 0; j < 8; ++j) hg[j] = p.hg[c0 + j];
#pragma unroll 1
            for (int tb4 = 0; tb4 < 8; tb4 += 4) {
                u32x4 lo[4], lg[4];
#pragma unroll
                for (int i = 0; i < 4; ++i) { const size_t t = t0 + tb4 + i; lo[i] = *(const u32x4*)(YH + t * 1024 + c0); lg[i] = *(const u32x4*)(GH + t * 1024 + c0); }
#pragma unroll
                for (int i = 0; i < 4; ++i) { const size_t t = t0 + tb4 + i;
                    float o[8], g[8]; unpack8(lo[i], o); unpack8(lg[i], g);
                    float s = 0.f;
#pragma unroll
                    for (int j = 0; j < 8; ++j) s += o[j] * o[j];
                    s = allred16(s);
                    const float rs = rsqrtf(s * (1.0f / 128.0f) + 1e-6f);
#pragma unroll
                    for (int j = 0; j < 8; ++j) o[j] = o[j] * rs * hg[j] * g[j];
                    const u32x4 w = {cvt_pk_bf16(o[0], o[1]), cvt_pk_bf16(o[2], o[3]), cvt_pk_bf16(o[4], o[5]), cvt_pk_bf16(o[6], o[7])};
                    *(u32x4*)(Y + t * DM + 1024 + c0) = w;
                }
            }
        }
    }
}

#ifndef DUP_PHASE
#define DUP_PHASE -1
#endif
#define RUN_PHASE(N, CALL) do { if (ph_lo <= (N) && (N) <= ph_hi) { if (ph_lo < (N)) xcd_barrier(xb); CALL; if ((N) == DUP_PHASE) { xcd_barrier(xb); CALL; } } } while (0)
__global__ void __launch_bounds__(512, 2) fwd_megakernel(Params p, int ph_lo, int ph_hi) {
    cg::grid_group grid = cg::this_grid();
    if (ph_lo < 0) grid.sync();
    volatile LAS unsigned* st = (volatile LAS unsigned*)((LAS unsigned char*)smem_raw + LDS_ST);
    if (threadIdx.x == 0) { st[0] = 0u; st[1] = 0u; st[2] = 0u; st[3] = 0u; }
    __syncthreads();
    const XcdBarrier xb = xcd_barrier_post(p.bar, st);
    RUN_PHASE(0, phase_prep0(p));
    RUN_PHASE(1, phase_gemm1(p));
    RUN_PHASE(2, phase_lora_in(p));
    RUN_PHASE(3, phase_gemm_lora(p));
    RUN_PHASE(4, phase_scan(p));
    RUN_PHASE(5, phase_post(p));
    RUN_PHASE(6, phase_gemm2(p));
}

extern "C" void kernel_launch(void* const* d_in, const int* in_sizes, int n_in, void* d_out, int out_size, void* d_ws, size_t ws_size, hipStream_t stream) {
    static int grid_blocks = 0;
    if (!grid_blocks) {
        int dev = 0, cus = 0, per_cu = 0;
        hipGetDevice(&dev);
        hipDeviceGetAttribute(&cus, hipDeviceAttributeMultiprocessorCount, dev);
        hipFuncSetAttribute((const void*)fwd_megakernel, hipFuncAttributeMaxDynamicSharedMemorySize, LDS_BYTES);
        hipOccupancyMaxActiveBlocksPerMultiprocessor(&per_cu, fwd_megakernel, 512, LDS_BYTES);
        if (per_cu < 1) per_cu = 1;
        grid_blocks = cus * per_cu;
        if (grid_blocks > 256) grid_blocks = 256;
    }
    if (ws_size < WS_END) { fprintf(stderr, "workspace too small: %zu < %zu\n", ws_size, (size_t)WS_END); return; }
    Params p{};
    p.x = (const float*)d_in[0]; p.norm_g = (const float*)d_in[1]; p.w_in = (const float*)d_in[2]; p.mu = (const float*)d_in[3];
    p.w0 = (const float*)d_in[4]; p.w2 = (const float*)d_in[5]; p.a0 = (const float*)d_in[6]; p.a2 = (const float*)d_in[7];
    p.k_k = (const float*)d_in[8]; p.k_a = (const float*)d_in[9]; p.r_k = (const float*)d_in[10]; p.lnx_w = (const float*)d_in[11];
    p.lnx_b = (const float*)d_in[12]; p.hg = (const float*)d_in[13]; p.lbp = (const float*)d_in[14]; p.w_out = (const float*)d_in[15];
    p.final_g = (const float*)d_in[16];
    p.out = (float*)d_out; p.ws = (unsigned char*)d_ws; p.bar = (unsigned*)((unsigned char*)d_ws + OFF_BAR);
    hipMemsetAsync((unsigned char*)d_ws + OFF_BAR, 0, 32768, stream);
#if MK_SINGLE
    int lo = 0, hi = 6;
    void* args[] = {&p, &lo, &hi};
    hipError_t e = hipLaunchCooperativeKernel((const void*)fwd_megakernel, dim3(grid_blocks), dim3(512), args, LDS_BYTES, stream);
    if (e != hipSuccess) fprintf(stderr, "cooperative launch failed: %s (grid %d)\n", hipGetErrorString(e), grid_blocks);
#else
    for (int ph = 0; ph <= 6; ++ph) fwd_megakernel<<<dim3(grid_blocks), dim3(512), LDS_BYTES, stream>>>(p, ph, ph);
#endif
}
```

```cpp
#include <hip/hip_runtime.h>
#include <hip/hip_cooperative_groups.h>
#include <cstdio>
#include <cstdint>
namespace cg = cooperative_groups;

#ifndef MK_SINGLE
#define MK_SINGLE 1
#endif

typedef unsigned short bf16_t;
using bf16x8 = __attribute__((ext_vector_type(8))) short;
using f32x4 = __attribute__((ext_vector_type(4))) float;
using u32x2 = __attribute__((ext_vector_type(2))) unsigned;
using u32x4 = __attribute__((ext_vector_type(4))) unsigned;

constexpr int NTOK = 8192, TSEQ = 4096, DM = 2048, NINP = 8448;
constexpr int BM = 256, BK = 64, HALF = 128, NXCD = 8, WGM = 8, HT = HALF * BK, SHM_B = 8 * HT * 2;

constexpr int LDS_ST = 149504, LDS_BYTES = LDS_ST + 32;
constexpr size_t OFF_HN = 0;
constexpr size_t OFF_WINT = 33554432;
constexpr size_t OFF_WOUTT = OFF_WINT + 34603008;
constexpr size_t OFF_Q = OFF_WOUTT + 8388608;
constexpr size_t OFF_F = OFF_Q + 16777216;
constexpr size_t OFF_I = OFF_F + 33554432;
constexpr size_t OFF_GH = OFF_I + 16777216;
constexpr size_t OFF_RKVG = OFF_GH + 16777216;
constexpr size_t OFF_WDAD = OFF_RKVG + 67108864;
constexpr size_t OFF_YR = OFF_WDAD + 8388608;
constexpr size_t OFF_SC = OFF_YR + 16777216;
constexpr size_t OFF_LA = OFF_SC + 524288;
constexpr size_t OFF_LB = OFF_LA + 4194304;
constexpr size_t OFF_WP3 = OFF_LB + 1048576;
constexpr size_t OFF_BAR = OFF_WP3 + 8388608;
constexpr size_t OFF_FLG = OFF_BAR + 16384;
constexpr size_t OFF_LBV = OFF_FLG + 16384;
constexpr size_t WS_END = OFF_LBV + 4096;
constexpr size_t OFF_RING_R = OFF_LA;
constexpr size_t OFF_RING_H = OFF_WDAD;
static_assert(OFF_RING_R + (size_t)32 * 4 * 8 * 12544 <= OFF_BAR, "RWKV ring overruns");
static_assert((size_t)16 * 4 * 8 * 13824 <= 8388608, "HGRN ring overruns");
__host__ __device__ constexpr size_t wp_off(int ks) { return ks == 0 ? OFF_WDAD : (ks == 1 ? OFF_YR : (ks == 2 ? OFF_YR + 8388608 : OFF_WP3)); }

struct Params {
    const float* x; const float* norm_g; const float* w_in; const float* mu; const float* w0; const float* w2;
    const float* a0; const float* a2; const float* k_k; const float* k_a; const float* r_k; const float* lnx_w;
    const float* lnx_b; const float* hg; const float* lbp; const float* w_out; const float* final_g;
    float* out; unsigned char* ws; unsigned* bar;
};

extern __shared__ __attribute__((aligned(16))) unsigned char smem_raw[];

__device__ __forceinline__ bf16_t f2bf(float f) { unsigned u = __float_as_uint(f); u += 0x7fffu + ((u >> 16) & 1u); return (bf16_t)(u >> 16); }
__device__ __forceinline__ float bf2f(bf16_t h) { return __uint_as_float(((unsigned)h) << 16); }
__device__ __forceinline__ unsigned pack2(float a, float b) { return (unsigned)f2bf(a) | ((unsigned)f2bf(b) << 16); }
__device__ __forceinline__ float wave_sum(float v) {
#pragma unroll
    for (int o = 32; o > 0; o >>= 1) v += __shfl_xor(v, o);
    return v;
}
template <int CTRL> __device__ __forceinline__ float dpp_f(float v) {
    return __int_as_float(__builtin_amdgcn_update_dpp(0, __float_as_int(v), CTRL, 0xf, 0xf, false));
}
__device__ __forceinline__ float allred16(float v) {
    v += dpp_f<0xB1>(v);
    v += dpp_f<0x4E>(v);
    v += dpp_f<0x124>(v);
    v += dpp_f<0x128>(v);
    return v;
}
typedef __attribute__((address_space(1))) unsigned gu32;
typedef __attribute__((address_space(1))) unsigned long long gu64;
typedef __attribute__((address_space(1))) float gf32;
#define SC_SPIN_CAP (1u << 22)
__device__ __forceinline__ unsigned sc_ld(unsigned* p) { return __hip_atomic_load((gu32*)p, __ATOMIC_RELAXED, __HIP_MEMORY_SCOPE_AGENT); }
__device__ __forceinline__ void sc_st(unsigned* p, unsigned v) { __hip_atomic_store((gu32*)p, v, __ATOMIC_RELAXED, __HIP_MEMORY_SCOPE_AGENT); }
__device__ __forceinline__ float sc_ldf(float* p) { return __hip_atomic_load((gf32*)p, __ATOMIC_RELAXED, __HIP_MEMORY_SCOPE_AGENT); }
__device__ __forceinline__ void sc_stf(float* p, float v) { __hip_atomic_store((gf32*)p, v, __ATOMIC_RELAXED, __HIP_MEMORY_SCOPE_AGENT); }
__device__ __forceinline__ void sc_wait_ge(unsigned* p, unsigned v) { unsigned sp = 0; while (sc_ld(p) < v) { __builtin_amdgcn_s_sleep(2); if (++sp > SC_SPIN_CAP) break; } }
__device__ __forceinline__ float sigmoidf_(float x) { return __builtin_amdgcn_rcpf(1.0f + __expf(-x)); }


#define LAS __attribute__((address_space(3)))
#define XB_TMO      128
#define XB_XCNT(j)  (256  + 64 * (j))
#define XB_XSUB(j)  (1280 + 64 * (j))
#define XB_XGEN(j)  (2304 + 64 * (j))
#define XB_TOP      3328
#define XB_TOPGEN   3392
#define XCD_BAR_WORDS 3456
#define XB_SPIN_CAP (1u << 18)
__device__ __forceinline__ unsigned xb_ld(unsigned* p)              { return __hip_atomic_load(p, __ATOMIC_RELAXED, __HIP_MEMORY_SCOPE_AGENT); }
__device__ __forceinline__ unsigned xb_add(unsigned* p, unsigned v) { return __hip_atomic_fetch_add(p, v, __ATOMIC_RELAXED, __HIP_MEMORY_SCOPE_AGENT); }
__device__ __forceinline__ unsigned xb_xcc_id() { return (unsigned)__builtin_amdgcn_s_getreg((3 << 11) | 20) & 0xFu; }
#define XB_SPIN(cond, bar) do { unsigned _sp = 0; while (cond) { __builtin_amdgcn_s_sleep(1); \
    if ((++_sp & 255u) == 0u) { if (xb_ld(&(bar)[XB_TMO])) break; if (_sp > XB_SPIN_CAP) { atomicAdd(&(bar)[XB_TMO], 1u); break; } } } } while (0)
struct XcdBarrier { unsigned* bar; unsigned x; volatile LAS unsigned* st; };
__device__ __forceinline__ XcdBarrier xcd_barrier_post(unsigned* bar, volatile LAS unsigned* st) {
    XcdBarrier b; b.bar = bar; b.x = xb_xcc_id(); b.st = st;
    if (threadIdx.x == 0) (void)xb_add(&bar[XB_XCNT(b.x)], 1u);
    return b;
}
__device__ __forceinline__ void xcd_barrier_complete(unsigned* bar, unsigned x, unsigned& nloc, unsigned& nx) {
    const unsigned G = gridDim.x * gridDim.y * gridDim.z;
    unsigned sum, cnt, mine, sp = 0u;
    for (;;) {
        sum = 0u; cnt = 0u; mine = 0u;
#pragma unroll
        for (unsigned j = 0; j < 16; ++j) { const unsigned c = xb_ld(&bar[XB_XCNT(j)]); sum += c; cnt += (c > 0u) ? 1u : 0u; mine = (j == x) ? c : mine; }
        if (sum == G) break;
        __builtin_amdgcn_s_sleep(1);
        if ((++sp & 255u) == 0u) { if (xb_ld(&bar[XB_TMO])) break; if (sp > XB_SPIN_CAP) { atomicAdd(&bar[XB_TMO], 1u); break; } }
    }
    nloc = mine > 0u ? mine : 1u; nx = cnt > 0u ? cnt : 1u;
}
__device__ __forceinline__ void xcd_barrier(const XcdBarrier& b) {
    asm volatile("s_waitcnt vmcnt(0)" ::: "memory");
    __syncthreads();
    if (threadIdx.x == 0) {
        unsigned* bar = b.bar;
        __builtin_amdgcn_s_waitcnt(0);
        unsigned nloc = b.st[0], nx = b.st[1];
        if (nloc == 0u) { xcd_barrier_complete(bar, b.x, nloc, nx); b.st[0] = nloc; b.st[1] = nx; }
        const unsigned old = xb_add(&bar[XB_XSUB(b.x)], 1u);
        const unsigned gen = old / nloc;
        if (old + 1u == (gen + 1u) * nloc) {
            __builtin_amdgcn_fence(__ATOMIC_RELEASE, "agent");
            asm volatile("s_waitcnt vmcnt(0)" ::: "memory");
            const unsigned og = xb_add(&bar[XB_TOP], 1u);
            const unsigned tg = og / nx;
            if (og + 1u == (tg + 1u) * nx) xb_add(&bar[XB_TOPGEN], 1u);
            else XB_SPIN(xb_ld(&bar[XB_TOPGEN]) == tg, bar);
            __builtin_amdgcn_fence(__ATOMIC_ACQUIRE, "agent");
            xb_add(&bar[XB_XGEN(b.x)], 1u);
            asm volatile("s_waitcnt vmcnt(0)" ::: "memory");
        } else {
            XB_SPIN(xb_ld(&bar[XB_XGEN(b.x)]) == gen, bar);
            __builtin_amdgcn_fence(__ATOMIC_ACQUIRE, "agent");
            asm volatile("s_waitcnt vmcnt(0)" ::: "memory");
        }
    }
    __syncthreads();
}

__device__ __forceinline__ int lds_byte(int r, int c) {
    int st = (r >> 4) * 2 + (c >> 5), rr = r & 15, cc = c & 31, ob = rr * 64 + cc * 2;
    return st * 1024 + (ob ^ (((ob >> 9) & 1) << 5));
}
__device__ __forceinline__ void stage_rc(int b, int& R, int& C) {
    int st = b / 1024, sb = b % 1024, swz = sb ^ (((sb >> 9) & 1) << 5);
    R = (st >> 1) * 16 + swz / 64; C = (st & 1) * 32 + (swz % 64) / 2;
}
__device__ __forceinline__ void unit_of(int L, int nM, int nN, int& pm, int& pn) {
    const int nwg = nM * nN; int wgid = L;
    { const int q = nwg / NXCD, r = nwg % NXCD, xcd = wgid % NXCD, off = wgid / NXCD; wgid = (xcd < r ? xcd * (q + 1) : r * (q + 1) + (xcd - r) * q) + off; }
    const int nig = WGM * nN, gid = wgid / nig, fm = gid * WGM, gsz = (nM - fm) < WGM ? (nM - fm) : WGM;
    pm = fm + ((wgid % nig) % gsz); pn = (wgid % nig) / gsz;
}

template <class Epi>
__device__ __forceinline__ void gemm_tile(const bf16_t* __restrict__ gA, const bf16_t* __restrict__ gB, const int K  , const int kbeg, const int nt  , const int pm, const int pn, const Epi& epi) {
    LAS unsigned char* lds = (LAS unsigned char*)smem_raw;
    constexpr int HTB = HT * 2;
    const int tid = threadIdx.x, wid = __builtin_amdgcn_readfirstlane(tid >> 6), lane = tid & 63, wr = wid >> 2, wc = wid & 3, fr = lane & 15, fq = lane >> 4;
    unsigned voff[2], voffB[2];
#pragma unroll
    for (int i = 0; i < 2; ++i) { int R, C; stage_rc(tid * 16 + i * 8192, R, C); voff[i] = (unsigned)(R * K + C) * 2u;
        const int rho = R & 31, Rb = (R & ~31) + 8 * ((rho & 15) >> 2) + 4 * (rho >> 4) + (rho & 3); voffB[i] = (unsigned)(Rb * K + C) * 2u; }
    const size_t kstep = (size_t)(BK * 2), hstep = (size_t)HALF * K * 2, tstep = 2 * hstep;
    const unsigned ldsw = (unsigned)wid * 1024u;
    const int aoff = lds_byte(wr * 64 + fr, fq * 8), boff = lds_byte(wc * 32 + fr, fq * 8);
    const char* cA = (const char*)gA + (size_t)pm * tstep + (size_t)kbeg * 2; const char* cB = (const char*)gB + (size_t)pn * tstep + (size_t)kbeg * 2;
#define SA(b, h) (((b) * 2 + (h)) * HTB)
#define SB(b, h) ((4 + (b) * 2 + (h)) * HTB)
#define STAGE(bufoff, gbase) do { _Pragma("unroll") for (int _i = 0; _i < 2; ++_i) \
    __builtin_amdgcn_global_load_lds((const unsigned*)((const char*)(gbase) + voff[_i]), (LAS unsigned*)(lds + (bufoff) + ldsw + _i * 8192), 16, 0, 0); } while (0)
#define STAGEB(bufoff, gbase) do { _Pragma("unroll") for (int _i = 0; _i < 2; ++_i) \
    __builtin_amdgcn_global_load_lds((const unsigned*)((const char*)(gbase) + voffB[_i]), (LAS unsigned*)(lds + (bufoff) + ldsw + _i * 8192), 16, 0, 0); } while (0)
#define LDA(dst, b, h) do { _Pragma("unroll") for (int m = 0; m < 4; ++m) _Pragma("unroll") for (int k = 0; k < 2; ++k) dst[m][k] = *(const LAS bf16x8*)(lds + SA(b, h) + aoff + m * 2048 + k * 1024); } while (0)
#define LDB(dst, b, h) do { _Pragma("unroll") for (int n = 0; n < 2; ++n) _Pragma("unroll") for (int k = 0; k < 2; ++k) dst[n][k] = *(const LAS bf16x8*)(lds + SB(b, h) + boff + n * 2048 + k * 1024); } while (0)
#define MMA(ai, bj, AT, BT) do { __builtin_amdgcn_s_setprio(1); _Pragma("unroll") for (int m = 0; m < 4; ++m) _Pragma("unroll") for (int n = 0; n < 2; ++n) _Pragma("unroll") for (int k = 0; k < 2; ++k) \
      acc[ai][bj][m][n] = __builtin_amdgcn_mfma_f32_16x16x32_bf16(BT[n][k], AT[m][k], acc[ai][bj][m][n], 0, 0, 0); \
    __builtin_amdgcn_s_setprio(0); } while (0)
#define WAIT_V(n) asm volatile("s_waitcnt vmcnt(" #n ")" ::: "memory")
#define WAIT_L(n) asm volatile("s_waitcnt lgkmcnt(" #n ")" ::: "memory")
#define BAR __builtin_amdgcn_s_barrier()
#define SCHED __builtin_amdgcn_sched_barrier(0)
    f32x4 acc[2][2][4][2];
#pragma unroll
    for (int a = 0; a < 2; ++a)
#pragma unroll
        for (int b = 0; b < 2; ++b)
#pragma unroll
            for (int m = 0; m < 4; ++m)
#pragma unroll
                for (int n = 0; n < 2; ++n) acc[a][b][m][n] = (f32x4){0.f, 0.f, 0.f, 0.f};
    bf16x8 At[4][2], B0[2][2], B1[2][2];
    STAGEB(SB(0, 0), cB); STAGE(SA(0, 0), cA); STAGEB(SB(0, 1), cB + hstep); STAGE(SA(0, 1), cA + hstep);
    if (wr == 1) BAR;
    WAIT_V(4); BAR;
    STAGEB(SB(1, 0), cB + kstep); STAGE(SA(1, 0), cA + kstep); STAGEB(SB(1, 1), cB + hstep + kstep);
    WAIT_V(6); BAR;
    for (int t = 0; t < nt - 2; t += 2) {
        const char* a1 = cA + (size_t)(t + 1) * kstep;
        const char* a2 = cA + (size_t)(t + 2) * kstep; const char* b2 = cB + (size_t)(t + 2) * kstep;
        const char* a3 = a2 + kstep; const char* b3 = b2 + kstep;
        LDB(B0, 0, 0); SCHED; LDA(At, 0, 0); STAGE(SA(1, 1), a1 + hstep);
        WAIT_L(8); BAR; WAIT_L(0); MMA(0, 0, At, B0); BAR; SCHED;
        LDB(B1, 0, 1); STAGEB(SB(0, 0), b2);
        BAR; WAIT_L(0); MMA(0, 1, At, B1); BAR;
        LDA(At, 0, 1); STAGE(SA(0, 0), a2);
        BAR; WAIT_L(0); MMA(1, 0, At, B0); BAR; SCHED;
        STAGEB(SB(0, 1), b2 + hstep);
        WAIT_V(6); BAR; MMA(1, 1, At, B1); BAR;
        LDB(B0, 1, 0); SCHED; LDA(At, 1, 0); STAGE(SA(0, 1), a2 + hstep);
        WAIT_L(8); BAR; WAIT_L(0); MMA(0, 0, At, B0); BAR; SCHED;
        LDB(B1, 1, 1); STAGEB(SB(1, 0), b3);
        BAR; WAIT_L(0); MMA(0, 1, At, B1); BAR;
        LDA(At, 1, 1); STAGE(SA(1, 0), a3);
        BAR; WAIT_L(0); MMA(1, 0, At, B0); BAR; SCHED;
        STAGEB(SB(1, 1), b3 + hstep);
        WAIT_V(6); BAR; MMA(1, 1, At, B1); BAR;
    }
    { const char* aL = cA + (size_t)(nt - 1) * kstep;
      LDB(B0, 0, 0); LDA(At, 0, 0); STAGE(SA(1, 1), aL + hstep);
      BAR; WAIT_L(0); MMA(0, 0, At, B0); BAR;
      LDB(B1, 0, 1); BAR; WAIT_L(0); MMA(0, 1, At, B1); BAR;
      LDA(At, 0, 1); WAIT_V(4); BAR; WAIT_L(0); MMA(1, 0, At, B0); MMA(1, 1, At, B1); BAR; }
    { LDB(B0, 1, 0); LDA(At, 1, 0); WAIT_V(2); BAR; WAIT_L(0); MMA(0, 0, At, B0); BAR;
      LDB(B1, 1, 1); WAIT_V(0); BAR; WAIT_L(0); MMA(0, 1, At, B1); BAR;
      LDA(At, 1, 1); BAR; WAIT_L(0); MMA(1, 0, At, B0); MMA(1, 1, At, B1); BAR; }
    if (wr == 0) BAR;
    if constexpr (Epi::FUSED) { __syncthreads(); epi.fused(acc, pm, pn, wr, wc, fr, fq); __syncthreads(); return; }
    const int brow = pm * BM;
#pragma unroll
    for (int ai = 0; ai < 2; ++ai)
#pragma unroll
        for (int m = 0; m < 4; ++m) {
#pragma unroll
            for (int bj = 0; bj < 2; ++bj)
                epi(acc[ai][bj][m][0], acc[ai][bj][m][1], brow + ai * HALF + wr * 64 + m * 16 + fr, bj * HALF + wc * 32 + fq * 8, pn);
            asm volatile("" ::: "memory");
        }
    __syncthreads();
#undef SA
#undef SB
#undef STAGE
#undef STAGEB
#undef LDA
#undef LDB
#undef MMA
}

struct Epi1 {
    static constexpr bool FUSED = false;
    unsigned char* ws; const float* lbp;
    __device__ __forceinline__ void operator()(const f32x4& v0, const f32x4& v1, int row, int cl, int pn) const {
        if (pn < 16) {
            const int sec = pn >> 2, c = (pn & 3) * 256 + cl;
            if (sec == 1) {
                f32x4 o0, o1;
                const f32x4 l0 = *(const f32x4*)(lbp + c), l1 = *(const f32x4*)(lbp + c + 4);
#pragma unroll
                for (int j = 0; j < 4; ++j) { o0[j] = l0[j] + (1.0f - l0[j]) * sigmoidf_(v0[j]); o1[j] = l1[j] + (1.0f - l1[j]) * sigmoidf_(v1[j]); }
                float* d = (float*)(ws + OFF_F) + (size_t)row * 1024 + c;
                *(f32x4*)d = o0; *(f32x4*)(d + 4) = o1;
            } else {
                bf16_t* dst = (bf16_t*)(ws + (sec == 0 ? OFF_Q : (sec == 2 ? OFF_I : OFF_GH))) + (size_t)row * 1024 + c;
                f32x4 o0 = v0, o1 = v1;
                if (sec == 3) {
#pragma unroll
                    for (int j = 0; j < 4; ++j) { o0[j] = v0[j] * sigmoidf_(v0[j]); o1[j] = v1[j] * sigmoidf_(v1[j]); }
                }
                uint4 w; w.x = pack2(o0[0], o0[1]); w.y = pack2(o0[2], o0[3]); w.z = pack2(o1[0], o1[1]); w.w = pack2(o1[2], o1[3]);
                *(uint4*)dst = w;
            }
        } else {
            bf16_t* dst = (bf16_t*)(ws + OFF_RKVG) + (size_t)row * 4096 + (pn - 16) * 256 + cl;
            uint4 w; w.x = pack2(v0[0], v0[1]); w.y = pack2(v0[2], v0[3]); w.z = pack2(v1[0], v1[1]); w.w = pack2(v1[2], v1[3]);
            *(uint4*)dst = w;
        }
    }
};
struct EpiPart {
    static constexpr bool FUSED = false;
    float* dst;
    __device__ __forceinline__ void operator()(const f32x4& v0, const f32x4& v1, int row, int cl, int pn) const {
        float* d = dst + (size_t)row * 256 + cl;
        *(f32x4*)d = v0; *(f32x4*)(d + 4) = v1;
    }
};
struct Epi2 {
    static constexpr bool FUSED = true;
    const float* x; float* out; const float* g; float* part; unsigned* cnt;
    __device__ __forceinline__ void fused(f32x4 (&acc)[2][2][4][2], int pm, int pn, int wr, int wc, int fr, int fq) const {
        LAS float* ssum = (LAS float*)smem_raw;
        LAS float* rsl = ssum + 1024;
        const int tid = threadIdx.x;
#pragma unroll
        for (int ai = 0; ai < 2; ++ai)
#pragma unroll
            for (int m = 0; m < 4; ++m) {
                const int r = ai * HALF + wr * 64 + m * 16 + fr; float s = 0.f;
#pragma unroll
                for (int bj = 0; bj < 2; ++bj)
#pragma unroll
                    for (int n = 0; n < 2; ++n) {
                        const f32x4 xv = *(const f32x4*)(x + (size_t)(pm * BM + r) * DM + pn * BM + bj * HALF + wc * 32 + fq * 8 + n * 4);
                        const f32x4 hv = acc[ai][bj][m][n] + xv; acc[ai][bj][m][n] = hv;
                        s += hv[0] * hv[0] + hv[1] * hv[1] + hv[2] * hv[2] + hv[3] * hv[3];
                    }
                s += __shfl_xor(s, 16); s += __shfl_xor(s, 32);
                if (fq == 0) ssum[r * 4 + wc] = s;
            }
        __syncthreads();
        if (tid < 256) sc_stf(part + (size_t)(pm * 8 + pn) * 256 + tid, (ssum[tid * 4] + ssum[tid * 4 + 1]) + (ssum[tid * 4 + 2] + ssum[tid * 4 + 3]));
        asm volatile("s_waitcnt vmcnt(0)" ::: "memory");
        __syncthreads();
        if (tid == 0) { __hip_atomic_fetch_add((gu32*)(cnt + pm * 16), 1u, __ATOMIC_RELAXED, __HIP_MEMORY_SCOPE_AGENT); sc_wait_ge(cnt + pm * 16, 8u); }
        __syncthreads();
        __builtin_amdgcn_fence(__ATOMIC_ACQUIRE, "agent");
        if (tid < 256) { float t = 0.f;
#pragma unroll
            for (int q = 0; q < 8; ++q) t += sc_ldf(part + (size_t)(pm * 8 + q) * 256 + tid);
            rsl[tid] = rsqrtf(t * (1.0f / DM) + 1e-6f); }
        __syncthreads();
#pragma unroll
        for (int ai = 0; ai < 2; ++ai)
#pragma unroll
            for (int m = 0; m < 4; ++m) {
                const int r = ai * HALF + wr * 64 + m * 16 + fr; const float rs = rsl[r];
#pragma unroll
                for (int bj = 0; bj < 2; ++bj)
#pragma unroll
                    for (int n = 0; n < 2; ++n) {
                        const int c = pn * BM + bj * HALF + wc * 32 + fq * 8 + n * 4;
                        const f32x4 gv = *(const f32x4*)(g + c);
                        *(f32x4*)(out + (size_t)(pm * BM + r) * DM + c) = acc[ai][bj][m][n] * rs * gv;
                    }
            }
    }
    __device__ __forceinline__ void operator()(const f32x4& v0, const f32x4& v1, int row, int cl, int pn) const {}
};
struct Epi3 {
    static constexpr bool FUSED = false;
    unsigned char* ws; const float* w0; const float* a0;
    __device__ __forceinline__ void operator()(const f32x4& v0, const f32x4& v1, int row, int cl, int pn) const {
        if (pn < 4) {
            const int c = pn * 256 + cl; const f32x4 b0 = *(const f32x4*)(w0 + c), b1 = *(const f32x4*)(w0 + c + 4); f32x4 o0, o1;
#pragma unroll
            for (int j = 0; j < 4; ++j) { o0[j] = __expf(-0.6065306597126334f * sigmoidf_(b0[j] + v0[j])); o1[j] = __expf(-0.6065306597126334f * sigmoidf_(b1[j] + v1[j])); }
            float* d = (float*)(ws + OFF_HN) + (size_t)row * 1024 + c;
            *(f32x4*)d = o0; *(f32x4*)(d + 4) = o1;
        } else {
            const int c = (pn - 4) * 256 + cl; const f32x4 b0 = *(const f32x4*)(a0 + c), b1 = *(const f32x4*)(a0 + c + 4);
            uint4 w; w.x = pack2(sigmoidf_(b0[0] + v0[0]), sigmoidf_(b0[1] + v0[1])); w.y = pack2(sigmoidf_(b0[2] + v0[2]), sigmoidf_(b0[3] + v0[3]));
            w.z = pack2(sigmoidf_(b1[0] + v1[0]), sigmoidf_(b1[1] + v1[1])); w.w = pack2(sigmoidf_(b1[2] + v1[2]), sigmoidf_(b1[3] + v1[3]));
            *(uint4*)((bf16_t*)(ws + OFF_WINT) + (size_t)row * 1024 + c) = w;
        }
    }
};

__device__ void build_lora_weights(const Params& p, int first, int stride) {
    bf16_t* lb = (bf16_t*)(p.ws + OFF_LB);
    for (int i = first; i < 2048 * 32; i += stride) {
        const int n = i >> 5, k0 = (i & 31) * 8; float e[8];
#pragma unroll
        for (int j = 0; j < 8; ++j) { const int k = k0 + j; float val = 0.f;
            if (n < 1024) { if (k < 96) val = p.w2[k * 1024 + n]; } else { if (k >= 128 && k < 224) val = p.a2[(k - 128) * 1024 + (n - 1024)]; }
            e[j] = val; }
        uint4 w; w.x = pack2(e[0], e[1]); w.y = pack2(e[2], e[3]); w.z = pack2(e[4], e[5]); w.w = pack2(e[6], e[7]);
        *(uint4*)(lb + (size_t)n * 256 + k0) = w;
    }
}
__device__ void prep_tiles(const Params& p, int t_begin, int t_end, int first, int stride) {
    const int tid = threadIdx.x;
    float* tile = (float*)smem_raw;
    bf16_t* wint = (bf16_t*)(p.ws + OFF_WINT);
    bf16_t* woutt = (bf16_t*)(p.ws + OFF_WOUTT);
    constexpr int NT1 = 132 * 32;
    const int lr = tid >> 4, lc = (tid & 15) * 4;
    f32x4 ld0, ld1; const f32x4 zero4 = {0.f, 0.f, 0.f, 0.f};
#define TR_DECODE(tl_) const float* src; int ld, c0; bf16_t* dst; int kt; \
        if ((tl_) < NT1) { const int ntile = (tl_) >> 5; kt = (tl_) & 31; const int n0 = ntile * 64; \
            c0 = n0 < 4096 ? 4288 + n0 : (n0 < 8192 ? n0 - 4096 : (n0 < 8384 ? 4096 + (n0 - 8192) : -1)); \
            src = p.w_in; ld = 8384; dst = wint + (size_t)n0 * DM; } \
        else { const int u = (tl_) - NT1; const int ntile = u >> 5; kt = u & 31; c0 = ntile * 64; src = p.w_out; ld = DM; dst = woutt + (size_t)ntile * 64 * DM; } \
        const int k0 = kt * 64;
#define TR_LOAD(tl_) do { TR_DECODE(tl_) (void)dst; \
        ld0 = c0 >= 0 ? *(const f32x4*)(src + (size_t)(k0 + lr) * ld + c0 + lc) : zero4; \
        ld1 = c0 >= 0 ? *(const f32x4*)(src + (size_t)(k0 + lr + 32) * ld + c0 + lc) : zero4; } while (0)
    if (t_begin + first < t_end) TR_LOAD(t_begin + first);
    for (int tl = t_begin + first; tl < t_end; tl += stride) {
        __syncthreads();
#pragma unroll
        for (int j = 0; j < 4; ++j) { tile[lr * 65 + lc + j] = ld0[j]; tile[(lr + 32) * 65 + lc + j] = ld1[j]; }
        __syncthreads();
        if (tl + stride < t_end) TR_LOAD(tl + stride);
        TR_DECODE(tl) (void)src; (void)ld; (void)c0;
        const int n = tid >> 3, ks = tid & 7;
        float e[8];
#pragma unroll
        for (int j = 0; j < 8; ++j) e[j] = tile[(ks * 8 + j) * 65 + n];
        uint4 w; w.x = pack2(e[0], e[1]); w.y = pack2(e[2], e[3]); w.z = pack2(e[4], e[5]); w.w = pack2(e[6], e[7]);
        *(uint4*)(dst + (size_t)n * DM + k0 + ks * 8) = w;
    }
#undef TR_LOAD
#undef TR_DECODE
    __syncthreads();
}

__device__ void phase_prep0(const Params& p) {
    const int tid = threadIdx.x, lane = tid & 63, wv = tid >> 6;
    const int gw = blockIdx.x * 8 + wv, nw = gridDim.x * 8;
    bf16_t* hn = (bf16_t*)(p.ws + OFF_HN);
    for (int row = gw; row < NTOK; row += nw) {
        const f32x4* xr = (const f32x4*)(p.x + (size_t)row * DM);
        f32x4 v[8]; float ss = 0.f;
#pragma unroll
        for (int i = 0; i < 8; ++i) { v[i] = xr[i * 64 + lane]; ss += v[i][0] * v[i][0] + v[i][1] * v[i][1] + v[i][2] * v[i][2] + v[i][3] * v[i][3]; }
        ss = wave_sum(ss);
        const float rs = rsqrtf(ss * (1.0f / DM) + 1e-6f);
#pragma unroll
        for (int i = 0; i < 8; ++i) {
            const f32x4 g = ((const f32x4*)p.norm_g)[i * 64 + lane];
            uint2 w; w.x = pack2(v[i][0] * rs * g[0], v[i][1] * rs * g[1]); w.y = pack2(v[i][2] * rs * g[2], v[i][3] * rs * g[3]);
            *(uint2*)(hn + (size_t)row * DM + (i * 64 + lane) * 4) = w;
        }
    }
    { const int i = blockIdx.x * 512 + tid; if (i < 1024) ((float*)(p.ws + OFF_LBV))[i] = sigmoidf_(p.lbp[i] - p.lbp[1024 + i]); }
    prep_tiles(p, 0, 132 * 32, blockIdx.x, gridDim.x);
}

__device__ void phase_gemm1(const Params& p) {
    const bf16_t* A = (const bf16_t*)(p.ws + OFF_HN);
    const bf16_t* B = (const bf16_t*)(p.ws + OFF_WINT);
    Epi1 epi{p.ws, (const float*)(p.ws + OFF_LBV)};
    for (int L = blockIdx.x; L < 32 * 32; L += gridDim.x) { int pm, pn; unit_of(L, 32, 32, pm, pn); gemm_tile(A, B, DM, 0, DM / BK, pm, pn, epi); }
    for (int it = blockIdx.x; it < 128; it += gridDim.x) { const int ks = it & 3; EpiPart ep{(float*)(p.ws + wp_off(ks))}; gemm_tile(A, B, DM, ks * 512, 8, it >> 2, 32, ep); }
    { const bool big = gridDim.x > 128; const int hb = big ? (int)blockIdx.x - 128 : (int)blockIdx.x, nh = big ? (int)gridDim.x - 128 : (int)gridDim.x;
      if (hb >= 0) { build_lora_weights(p, hb * 512 + threadIdx.x, nh * 512); prep_tiles(p, 132 * 32, 132 * 32 + 32 * 32, hb, nh); } }
}
__device__ void phase_gemm_lora(const Params& p) {
    const bf16_t* A = (const bf16_t*)(p.ws + OFF_LA);
    const bf16_t* B = (const bf16_t*)(p.ws + OFF_LB);
    Epi3 epi{p.ws, p.w0, p.a0};
    for (int L = blockIdx.x; L < 32 * 8; L += gridDim.x) { int pm, pn; unit_of(L, 32, 8, pm, pn); gemm_tile(A, B, 256, pn < 4 ? 0 : 128, 2, pm, pn, epi); }
}
__device__ void phase_gemm2(const Params& p) {
    const bf16_t* A = (const bf16_t*)(p.ws + OFF_F);
    const bf16_t* B = (const bf16_t*)(p.ws + OFF_WOUTT);
    Epi2 epi{p.x, p.out, p.final_g, (float*)(p.ws + OFF_WDAD), (unsigned*)(p.ws + OFF_FLG) + 48 * 64};
    for (int L = blockIdx.x; L < 32 * 8; L += gridDim.x) { int pm, pn; unit_of(L, 32, 8, pm, pn); gemm_tile(A, B, DM, 0, DM / BK, pm, pn, epi); }
}

__device__ __forceinline__ float tanh_fast(float x) { return 1.0f - 2.0f / (__expf(2.0f * x) + 1.0f); }
__device__ __forceinline__ float bflo(unsigned u) { return __uint_as_float(u << 16); }
__device__ __forceinline__ float bfhi(unsigned u) { return __uint_as_float(u & 0xffff0000u); }

__device__ void phase_lora_in(const Params& p) {
    const int tid = threadIdx.x, lane = tid & 63, wv = tid >> 6;
    const int gw = blockIdx.x * 8 + wv, nw = gridDim.x * 8;
    const bf16_t* rkvg = (const bf16_t*)(p.ws + OFF_RKVG);
    bf16_t* la = (bf16_t*)(p.ws + OFF_LA);
    float* inv = (float*)(p.ws + OFF_SC);
    const int o = 4 * lane, sidx = o < 128 ? o : o - 32; const bool valid = (o & 127) < 96;
    const f32x4 zero4 = {0.f, 0.f, 0.f, 0.f};
    const f32x4 mu4 = valid ? *(const f32x4*)(p.mu + 4096 + sidx) : zero4;
    float muk[16], ckk[16];
#pragma unroll
    for (int j = 0; j < 16; ++j) { muk[j] = p.mu[1024 + 16 * lane + j]; ckk[j] = p.k_k[16 * lane + j]; }
    for (int t = gw; t < NTOK; t += nw) {
        const bool first = (t & (TSEQ - 1)) == 0;
        f32x4 cur = zero4, prv = zero4;
        if (valid) {
#pragma unroll
            for (int ks = 0; ks < 4; ++ks) { const float* wp = (const float*)(p.ws + wp_off(ks));
                cur += *(const f32x4*)(wp + (size_t)t * 256 + sidx);
                if (!first) prv += *(const f32x4*)(wp + (size_t)(t - 1) * 256 + sidx); }
        }
        const uint4 kc0 = *(const uint4*)(rkvg + (size_t)t * 4096 + 1024 + 16 * lane), kc1 = *(const uint4*)(rkvg + (size_t)t * 4096 + 1024 + 16 * lane + 8);
        uint4 kp0 = {0, 0, 0, 0}, kp1 = {0, 0, 0, 0};
        if (!first) { kp0 = *(const uint4*)(rkvg + (size_t)(t - 1) * 4096 + 1024 + 16 * lane); kp1 = *(const uint4*)(rkvg + (size_t)(t - 1) * 4096 + 1024 + 16 * lane + 8); }
        f32x4 m = cur + mu4 * (prv - cur);
        if (o < 128) {
#pragma unroll
            for (int j = 0; j < 4; ++j) m[j] = tanh_fast(m[j]);
        }
        uint2 w; w.x = pack2(m[0], m[1]); w.y = pack2(m[2], m[3]);
        *(uint2*)(la + (size_t)t * 256 + o) = w;
        const unsigned kcw[8] = {kc0.x, kc0.y, kc0.z, kc0.w, kc1.x, kc1.y, kc1.z, kc1.w};
        const unsigned kpw[8] = {kp0.x, kp0.y, kp0.z, kp0.w, kp1.x, kp1.y, kp1.z, kp1.w};
        float ss = 0.f;
#pragma unroll
        for (int j = 0; j < 8; ++j) {
            const float c0 = bflo(kcw[j]), c1 = bfhi(kcw[j]), p0 = bflo(kpw[j]), p1 = bfhi(kpw[j]);
            const float k0 = (c0 + muk[2 * j] * (p0 - c0)) * ckk[2 * j], k1 = (c1 + muk[2 * j + 1] * (p1 - c1)) * ckk[2 * j + 1];
            ss += k0 * k0 + k1 * k1;
        }
        ss += dpp_f<0xB1>(ss); ss += dpp_f<0x4E>(ss);
        if ((lane & 3) == 0) inv[(size_t)t * 16 + (lane >> 2)] = 1.0f / fmaxf(sqrtf(ss), 1e-12f);
    }
}

__device__ __forceinline__ void sc_publish_lds(unsigned char* g, int nbytes) {
    LAS unsigned char* lds = (LAS unsigned char*)smem_raw;
    const __amdgpu_buffer_rsrc_t rsrc = __builtin_amdgcn_make_buffer_rsrc(g, 0, nbytes, 0x00020000);
    for (int i = threadIdx.x * 16; i < nbytes; i += 512 * 16)
        __builtin_amdgcn_raw_buffer_store_b128(*(const LAS u32x4*)(lds + i), rsrc, (unsigned)i, 0,   16);
    asm volatile("s_waitcnt vmcnt(0)" ::: "memory");
}

__device__ __forceinline__ bf16x8 mk8(unsigned a, unsigned b, unsigned c, unsigned d) {
    union { unsigned u[4]; bf16x8 v; } x; x.u[0] = a; x.u[1] = b; x.u[2] = c; x.u[3] = d; return x.v;
}
typedef float f32x2_t __attribute__((ext_vector_type(2)));
typedef __bf16 bf16x2_t __attribute__((ext_vector_type(2)));
__device__ __forceinline__ unsigned cvt_pk_bf16(float lo, float hi) { const f32x2_t v = {lo, hi}; const bf16x2_t b = __builtin_convertvector(v, bf16x2_t); return __builtin_bit_cast(unsigned, b); }
#define ST_LO(ptr, u) (*(LAS bf16_t*)(ptr) = (bf16_t)((u) & 0xffffu))
#define ST_HI(ptr, u) (*(LAS bf16_t*)(ptr) = (bf16_t)((u) >> 16))
__device__ __forceinline__ int tile_off(int m, int fq, int row) { return m * 1024 + (fq * 16 + ((row + 4 * fq + m) & 15)) * 16; }
template <int PROD> __device__ void scan_hgrn_chunk(const Params& p, int bh, int pj) {
    LAS unsigned char* lds = (LAS unsigned char*)smem_raw;
    constexpr int SLOT = 13824, QF_O = 0, KF_O = 4096, AF_O = 8192, GC_O = 9216, VF_O = 9728, KT_BASE = 8 * SLOT;
    const int tid = threadIdx.x, lane = tid & 63, wv = tid >> 6, fr = lane & 15, fq = lane >> 4;
    const int b = bh >> 3, h = bh & 7;
    const size_t tb = (size_t)b * TSEQ;
    const bf16_t* Q = (const bf16_t*)(p.ws + OFF_Q) + h * 128;
    const float* F = (const float*)(p.ws + OFF_F) + h * 128;
    const bf16_t* I = (const bf16_t*)(p.ws + OFF_I) + h * 128 + wv * 16 + fr;
    const int vb = PROD == 2 ? pj * 4 + (wv & 3) : wv;
    bf16_t* YH = (bf16_t*)(p.ws + OFF_WINT) + (size_t)NTOK * 1024 + h * 128 + vb * 16 + fr;
    const bf16_t* Icol = (const bf16_t*)(p.ws + OFF_I) + h * 128;
    f32x4 Sacc[8];
#pragma unroll
    for (int i = 0; i < 8; ++i) Sacc[i] = (f32x4){0.f, 0.f, 0.f, 0.f};
    const int k0 = lane, k1 = lane + 64;
    const int qb0 = (k0 >> 5) * 1024 + ((k0 >> 2) & 3) * 256 + (((k0 >> 4) & 1) * 4 + (k0 & 3)) * 2, rot0 = 4 * ((k0 >> 2) & 3) + (k0 >> 5);
    const int qb1 = (k1 >> 5) * 1024 + ((k1 >> 2) & 3) * 256 + (((k1 >> 4) & 1) * 4 + (k1 & 3)) * 2, rot1 = 4 * ((k1 >> 2) & 3) + (k1 >> 5);
    int rdo[4];
#pragma unroll
    for (int m = 0; m < 4; ++m) rdo[m] = tile_off(m, fq, fr);
    const int ko0 = (((k0 >> 4) * 64 + (k0 & 15)) * 4) * 2, ko1 = (((k1 >> 4) * 64 + (k1 & 15)) * 4) * 2;
    unsigned short vcur[4], vnxt[4], raw_q0[16], raw_q1[16], raw_i0[16], raw_i1[16]; float raw_f0[16], raw_f1[16];
#define HG_PREFETCH(rnd) do { const size_t t0_ = tb + (size_t)((rnd) * 8 + wv) * 16; \
        _Pragma("unroll") for (int t_ = 0; t_ < 16; ++t_) { raw_q0[t_] = Q[(t0_ + t_) * 1024 + k0]; raw_q1[t_] = Q[(t0_ + t_) * 1024 + k1]; \
            raw_f0[t_] = F[(t0_ + t_) * 1024 + k0]; raw_f1[t_] = F[(t0_ + t_) * 1024 + k1]; \
            if (PROD == 1) { raw_i0[t_] = Icol[(t0_ + t_) * 1024 + k0]; raw_i1[t_] = Icol[(t0_ + t_) * 1024 + k1]; } } } while (0)
    unsigned* flg = (unsigned*)(p.ws + OFF_FLG) + (32 + bh) * 64;
    const unsigned char* ring = p.ws + OFF_RING_H + (size_t)bh * 4 * 8 * SLOT;
    constexpr int NCP = (4 * SLOT + 4095) / 4096;
    const bool stager = wv >= 4;
    u32x4 cp[NCP];
#define RING_LOADH(hr_) do { const unsigned char* s_ = ring + (size_t)((((hr_) >> 1) & 3) * 8 + ((hr_) & 1) * 4) * SLOT;     \
        _Pragma("unroll") for (int i_ = 0; i_ < NCP; ++i_) { int o_ = i_ * 4096 + (tid - 256) * 16; o_ = o_ < 4 * SLOT ? o_ : 4 * SLOT - 16; cp[i_] = *(const u32x4*)(s_ + o_); } } while (0)
#define CP_TO_LDS(hr_) do { LAS unsigned char* d_ = lds + ((hr_) & 1) * 4 * SLOT; \
        _Pragma("unroll") for (int i_ = 0; i_ < NCP; ++i_) { int o_ = i_ * 4096 + (tid - 256) * 16; o_ = o_ < 4 * SLOT ? o_ : 4 * SLOT - 16; *(LAS u32x4*)(d_ + o_) = cp[i_]; } } while (0)
    unsigned early = 0u;
    if (PROD == 2) { if (stager) { sc_wait_ge(flg + 0, 1u); __builtin_amdgcn_fence(__ATOMIC_ACQUIRE, "agent"); RING_LOADH(0); CP_TO_LDS(0); RING_LOADH(1); } }
    else HG_PREFETCH(PROD ? pj : 0);
    constexpr int NJ = PROD == 2 ? 4 : 8;
    for (int round = PROD == 1 ? pj : 0; round < (PROD == 2 ? TSEQ / 64 : TSEQ / 128); round += PROD == 1 ? 4 : 1) {
        __syncthreads();
        if (PROD == 0) {
#pragma unroll
            for (int jj = 0; jj < 4; ++jj) vcur[jj] = I[(tb + (size_t)(round * 8) * 16 + fq * 4 + jj) * 1024];
        }
        if (PROD == 2) {
            const int hr = round;
            if (stager) {
                if ((hr & 1) && tid == 256) sc_st(flg + 16 + pj, (unsigned)((hr >> 1) + 1));
                if (hr + 1 < TSEQ / 64) CP_TO_LDS(hr + 1);
                if (hr + 2 < TSEQ / 64) {
                    if (((hr + 2) & 1) == 0) { const int rn = (hr + 2) >> 1; if (early < (unsigned)(rn + 1)) sc_wait_ge(flg + (rn & 3), (unsigned)(rn + 1)); __builtin_amdgcn_fence(__ATOMIC_ACQUIRE, "agent"); }
                    RING_LOADH(hr + 2);
                    if (((hr + 2) & 1) == 0) early = sc_ld(flg + ((((hr + 2) >> 1) + 1) & 3));
                }
            }
        } else
        {
            LAS unsigned char* slot = lds + wv * SLOT; LAS unsigned char* kt = lds + KT_BASE + wv * 4096;
            float G0 = 1.f, G1 = 1.f;
            int rot0v = rot0, rot1v = rot1; asm volatile("" : "+v"(rot0v), "+v"(rot1v));
#pragma unroll
            for (int t = 0; t < 16; ++t) {
                const float q0 = bf2f(raw_q0[t]), q1 = bf2f(raw_q1[t]);
                const float f0 = raw_f0[t], f1 = raw_f1[t];
                G0 *= f0; G1 *= f1;
                const float r0 = __builtin_amdgcn_rcpf(G0), r1 = __builtin_amdgcn_rcpf(G1);
                const int qo0 = qb0 + (((t + rot0v) & 15) << 4), qo1 = qb1 + (((t + rot1v) & 15) << 4);
                const unsigned uq = cvt_pk_bf16(q0 * G0, q1 * G1), uk = cvt_pk_bf16((1.0f - f0) * r0, (1.0f - f1) * r1);
                ST_LO(slot + QF_O + qo0, uq); ST_HI(slot + QF_O + qo1, uq);
                ST_LO(kt + qo0, uk); ST_HI(kt + qo1, uk);
            }
            *(LAS float*)(slot + GC_O + k0 * 4) = G0; *(LAS float*)(slot + GC_O + k1 * 4) = G1;
            if (PROD == 1) {
#pragma unroll
                for (int s = 0; s < 16; s += 2) {
                    *(LAS unsigned*)(slot + VF_O + (((k0 >> 4) * 64 + (s >> 2) * 16 + (k0 & 15)) * 4 + (s & 3)) * 2) = (unsigned)raw_i0[s] | ((unsigned)raw_i0[s + 1] << 16);
                    *(LAS unsigned*)(slot + VF_O + (((k1 >> 4) * 64 + (s >> 2) * 16 + (k1 & 15)) * 4 + (s & 3)) * 2) = (unsigned)raw_i1[s] | ((unsigned)raw_i1[s + 1] << 16);
                }
            }
            int rot0w = rot0, rot1w = rot1; asm volatile("" : "+v"(rot0w), "+v"(rot1w));
#pragma unroll
            for (int s = 0; s < 16; ++s) {
                const float ka = bf2f(*(const LAS bf16_t*)(kt + qb0 + (((s + rot0w) & 15) << 4))), kb_ = bf2f(*(const LAS bf16_t*)(kt + qb1 + (((s + rot1w) & 15) << 4)));
                const unsigned u = cvt_pk_bf16(ka * G0, kb_ * G1);
                ST_LO(slot + KF_O + ko0 + ((s >> 2) * 16 * 4 + (s & 3)) * 2, u);
                ST_HI(slot + KF_O + ko1 + ((s >> 2) * 16 * 4 + (s & 3)) * 2, u);
            }
            *(LAS u32x2*)(slot + AF_O + lane * 16 + 8) = (u32x2){0u, 0u};
            asm volatile("s_waitcnt lgkmcnt(0)" ::: "memory");
            f32x4 d = {0.f, 0.f, 0.f, 0.f};
#pragma unroll
            for (int m = 0; m < 4; ++m) {
                const bf16x8 a = *(const LAS bf16x8*)(slot + QF_O + rdo[m]), bb = *(const LAS bf16x8*)(kt + rdo[m]);
                d = __builtin_amdgcn_mfma_f32_16x16x32_bf16(a, bb, d, 0, 0, 0);
            }
#pragma unroll
            for (int r = 0; r < 4; ++r) { const int t = fq * 4 + r, s = fr;
                const unsigned u = cvt_pk_bf16(s <= t ? d[r] : 0.f, 0.f);
                ST_LO(slot + AF_O + (((s >> 2) * 16 + t) * 8 + (s & 3)) * 2, u); }
        }
        if (PROD != 2) __syncthreads();
        if (PROD == 2) {
        } else if (PROD == 1) {
            if (round + 4 < TSEQ / 128) HG_PREFETCH(round + 4);
            if (round >= 4) { if (tid < 2) sc_wait_ge(flg + 16 + tid, (unsigned)(round - 3)); __syncthreads(); }
            sc_publish_lds(p.ws + OFF_RING_H + ((size_t)bh * 4 + pj) * 8 * SLOT, 8 * SLOT);
            __syncthreads();
            if (tid == 0) sc_st(flg + pj, (unsigned)(round + 1));
            continue;
        } else if (round + 1 < TSEQ / 128) HG_PREFETCH(round + 1);
        if (PROD == 2 && !stager) {
            bf16x8 fa[5]; u32x2 fk[8], fv; f32x4 fg[8];
#define WLDG(j_) do { LAS unsigned char* s_ = lds + ((round & 1) * 4 + (j_)) * SLOT; \
                _Pragma("unroll") for (int kb_ = 0; kb_ < 8; ++kb_) fg[kb_] = *(const LAS f32x4*)(s_ + GC_O + (kb_ * 16 + fq * 4) * 4); } while (0)
#define WLDH(A_, K_, V_, j_) do { LAS unsigned char* s_ = lds + ((round & 1) * 4 + (j_)) * SLOT; \
                _Pragma("unroll") for (int m_ = 0; m_ < 4; ++m_) A_[m_] = *(const LAS bf16x8*)(s_ + QF_O + rdo[m_]); \
                A_[4] = *(const LAS bf16x8*)(s_ + AF_O + lane * 16); \
                _Pragma("unroll") for (int kb_ = 0; kb_ < 8; ++kb_) K_[kb_] = *(const LAS u32x2*)(s_ + KF_O + (kb_ * 64 + lane) * 8); \
                V_ = *(const LAS u32x2*)(s_ + VF_O + (vb * 64 + lane) * 8); } while (0)
            WLDH(fa, fk, fv, 0); WLDG(0);
#pragma unroll
            for (int j = 0; j < NJ; ++j) {
                bf16x8 na[5]; u32x2 nk[8], nv;
                if (j + 1 < NJ) WLDH(na, nk, nv, j + 1);
                const bf16x8 Vb = mk8(fv.x, fv.y, 0u, 0u);
                f32x4 o = {0.f, 0.f, 0.f, 0.f};
#pragma unroll
                for (int m = 0; m < 4; ++m) {
                    const bf16x8 sb = mk8(cvt_pk_bf16(Sacc[2 * m][0], Sacc[2 * m][1]), cvt_pk_bf16(Sacc[2 * m][2], Sacc[2 * m][3]), cvt_pk_bf16(Sacc[2 * m + 1][0], Sacc[2 * m + 1][1]), cvt_pk_bf16(Sacc[2 * m + 1][2], Sacc[2 * m + 1][3]));
                    o = __builtin_amdgcn_mfma_f32_16x16x32_bf16(fa[m], sb, o, 0, 0, 0);
                }
                o = __builtin_amdgcn_mfma_f32_16x16x32_bf16(fa[4], Vb, o, 0, 0, 0);
#pragma unroll
                for (int kb = 0; kb < 8; ++kb) Sacc[kb] = __builtin_amdgcn_mfma_f32_16x16x32_bf16(mk8(fk[kb].x, fk[kb].y, 0u, 0u), Vb, Sacc[kb] * fg[kb], 0, 0, 0);
                if (j + 1 < NJ) WLDG(j + 1);
                { bf16_t* yo = YH + (tb + (size_t)(round * NJ + j) * 16 + fq * 4) * 1024;
                  const unsigned y01 = cvt_pk_bf16(o[0], o[1]), y23 = cvt_pk_bf16(o[2], o[3]);
                  yo[0] = (bf16_t)(y01 & 0xffffu); yo[1024] = (bf16_t)(y01 >> 16); yo[2048] = (bf16_t)(y23 & 0xffffu); yo[3072] = (bf16_t)(y23 >> 16); }
                if (j + 1 < NJ) {
#pragma unroll
                    for (int i = 0; i < 5; ++i) fa[i] = na[i];
#pragma unroll
                    for (int i = 0; i < 8; ++i) fk[i] = nk[i];
                    fv = nv;
                }
            }
#undef WLDH
#undef WLDG
        }
    }
    __syncthreads();
}


template <int PROD> __device__ void scan_rwkv_chunk(const Params& p, int bh, int pj) {
    LAS unsigned char* lds = (LAS unsigned char*)smem_raw;
    constexpr int SLOT = 12544, WA_O = 0, RT_O = 2048, MAK_O = 4096, RBK_O = 5120, KB_O = 6144, GC_O = 10240, VF_O = 10496, TMP_BASE = 8 * SLOT, TMP = 6144;
    const int tid = threadIdx.x, lane = tid & 63, wv = tid >> 6, fr = lane & 15, fq = lane >> 4;
    const int b = bh >> 4, h = bh & 15;
    const size_t tb = (size_t)b * TSEQ;
    const bf16_t* rkvg = (const bf16_t*)(p.ws + OFF_RKVG);
    const float* Wd = (const float*)(p.ws + OFF_HN);
    const bf16_t* As = (const bf16_t*)(p.ws + OFF_WINT);
    const float* invp = (const float*)(p.ws + OFF_SC);
    bf16_t* YR = (bf16_t*)(p.ws + OFF_YR) + h * 64 + wv * 16 + fr;
    const int col = h * 64 + lane;
    const float mur = p.mu[col], muk = p.mu[1024 + col], muv = p.mu[2048 + col], ckk = p.k_k[col], cka = p.k_a[col];
    const int qb = (lane >> 5) * 1024 + ((lane >> 2) & 3) * 256 + (((lane >> 4) & 1) * 4 + (lane & 3)) * 2, rot = 4 * ((lane >> 2) & 3) + (lane >> 5);
    const int rd0 = tile_off(0, fq, fr), rd1 = tile_off(1, fq, fr);
    const int kbo = KB_O + (lane >> 4) * 1024 + (lane & 15) * 16;
    const int vfo = VF_O + (((lane >> 4) * 64 + (lane & 15)) * 4) * 2;
    f32x4 Sacc[4];
#pragma unroll
    for (int i = 0; i < 4; ++i) Sacc[i] = (f32x4){0.f, 0.f, 0.f, 0.f};
    unsigned short raw_r[16], raw_k[16], raw_v[16], raw_a[16], raw_rp, raw_kp, raw_vp; float raw_w[16], raw_i[16];
#define RW_PREFETCH(rnd) do { const int c_ = (rnd) * 8 + wv; const size_t t0_ = tb + (size_t)c_ * 16; \
        raw_rp = 0; raw_kp = 0; raw_vp = 0; \
        if (c_ > 0) { const bf16_t* pr_ = rkvg + (t0_ - 1) * 4096 + col; raw_rp = pr_[0]; raw_kp = pr_[1024]; raw_vp = pr_[2048]; } \
        _Pragma("unroll") for (int t_ = 0; t_ < 16; ++t_) { const bf16_t* pr_ = rkvg + (t0_ + t_) * 4096 + col; \
            raw_r[t_] = pr_[0]; raw_k[t_] = pr_[1024]; raw_v[t_] = pr_[2048]; \
            raw_w[t_] = Wd[(t0_ + t_) * 1024 + col]; raw_a[t_] = As[(t0_ + t_) * 1024 + col]; raw_i[t_] = invp[(t0_ + t_) * 16 + h]; } } while (0)
    unsigned* flg = (unsigned*)(p.ws + OFF_FLG) + bh * 64;
    const unsigned char* ring = p.ws + OFF_RING_R + (size_t)bh * 4 * 8 * SLOT;
    constexpr int NCP = (4 * SLOT + 4095) / 4096;
    const bool stager = wv >= 4;
    u32x4 cp[NCP];
#define RING_LOAD(hr_) do { const unsigned char* s_ = ring + (size_t)((((hr_) >> 1) & 3) * 8 + ((hr_) & 1) * 4) * SLOT;     \
        _Pragma("unroll") for (int i_ = 0; i_ < NCP; ++i_) { int o_ = i_ * 4096 + (tid - 256) * 16; o_ = o_ < 4 * SLOT ? o_ : 4 * SLOT - 16; cp[i_] = *(const u32x4*)(s_ + o_); } } while (0)
#define CP_TO_LDS(hr_) do { LAS unsigned char* d_ = lds + ((hr_) & 1) * 4 * SLOT; \
        _Pragma("unroll") for (int i_ = 0; i_ < NCP; ++i_) { int o_ = i_ * 4096 + (tid - 256) * 16; o_ = o_ < 4 * SLOT ? o_ : 4 * SLOT - 16; *(LAS u32x4*)(d_ + o_) = cp[i_]; } } while (0)
    unsigned early = 0u;
    if (PROD == 2) { if (stager) { sc_wait_ge(flg + 0, 1u); __builtin_amdgcn_fence(__ATOMIC_ACQUIRE, "agent"); RING_LOAD(0); CP_TO_LDS(0); RING_LOAD(1); } }
    else RW_PREFETCH(PROD ? pj : 0);
    constexpr int NJ = PROD == 2 ? 4 : 8;
    for (int round = PROD == 1 ? pj : 0; round < (PROD == 2 ? TSEQ / 64 : TSEQ / 128); round += PROD == 1 ? 4 : 1) {
        __syncthreads();
        if (PROD == 2) {
            const int hr = round;
            if (stager) {
                if ((hr & 1) && tid == 256) sc_st(flg + 16, (unsigned)((hr >> 1) + 1));
                if (hr + 1 < TSEQ / 64) CP_TO_LDS(hr + 1);
                if (hr + 2 < TSEQ / 64) {
                    if (((hr + 2) & 1) == 0) { const int rn = (hr + 2) >> 1; if (early < (unsigned)(rn + 1)) sc_wait_ge(flg + (rn & 3), (unsigned)(rn + 1)); __builtin_amdgcn_fence(__ATOMIC_ACQUIRE, "agent"); }
                    RING_LOAD(hr + 2);
                    if (((hr + 2) & 1) == 0) early = sc_ld(flg + ((((hr + 2) >> 1) + 1) & 3));
                }
            }
        } else
        {
            LAS unsigned char* slot = lds + wv * SLOT; LAS unsigned char* tmp = lds + TMP_BASE + wv * TMP;
            float rp = bf2f(raw_rp), kp = bf2f(raw_kp), vp = bf2f(raw_vp);
            float G = 1.f, at[16], bt[16], kt[16];
            int rotv = rot; asm volatile("" : "+v"(rotv));
#pragma unroll
            for (int t = 0; t < 16; ++t) {
                const float rc = bf2f(raw_r[t]), kc = bf2f(raw_k[t]), vc = bf2f(raw_v[t]);
                const float w = raw_w[t], as = bf2f(raw_a[t]), iv = raw_i[t];
                const float r = rc + mur * (rp - rc), kx = kc + muk * (kp - kc), vm = vc + muv * (vp - vc);
                rp = rc; kp = kc; vp = vc;
                const float kkn = kx * ckk * iv, bb = kkn * as, k2 = kx * (1.0f + (as - 1.0f) * cka);
                const float Gp = G; G *= w; const float rG = __builtin_amdgcn_rcpf(G);
                const int qo = qb + (((t + rotv) & 15) << 4);
                at[t] = -kkn * Gp; bt[t] = bb * rG; kt[t] = k2 * rG;
                const unsigned u0 = cvt_pk_bf16(at[t], bt[t]), u1 = cvt_pk_bf16(kt[t], r * G), u2 = cvt_pk_bf16(vm, vm);
                ST_LO(tmp + qo, u0); ST_HI(tmp + 2048 + qo, u0);
                ST_LO(tmp + 4096 + qo, u1); ST_HI(slot + RT_O + qo, u1);
                ST_LO(slot + vfo + (t >> 2) * 128 + (t & 3) * 2, u2);
            }
            *(LAS float*)(slot + GC_O + lane * 4) = G;
#pragma unroll
            for (int s = 0; s < 16; ++s) {
                const unsigned u = cvt_pk_bf16(bt[s] * G, kt[s] * G);
                ST_LO(slot + kbo + (s >> 2) * 256 + (s & 3) * 2, u);
                ST_HI(slot + kbo + (s >> 2) * 256 + 8 + (s & 3) * 2, u);
            }
            *(LAS u32x2*)(slot + MAK_O + lane * 16) = (u32x2){0u, 0u};
            asm volatile("s_waitcnt lgkmcnt(0)" ::: "memory");
            f32x4 dab = {0.f, 0.f, 0.f, 0.f}, dak = dab, drb = dab, drk = dab;
#pragma unroll
            for (int m = 0; m < 2; ++m) {
                const int rd = m ? rd1 : rd0;
                const bf16x8 aA = *(const LAS bf16x8*)(tmp + rd), aR = *(const LAS bf16x8*)(slot + RT_O + rd);
                const bf16x8 bB = *(const LAS bf16x8*)(tmp + 2048 + rd), bK = *(const LAS bf16x8*)(tmp + 4096 + rd);
                dab = __builtin_amdgcn_mfma_f32_16x16x32_bf16(aA, bB, dab, 0, 0, 0);
                dak = __builtin_amdgcn_mfma_f32_16x16x32_bf16(aA, bK, dak, 0, 0, 0);
                drb = __builtin_amdgcn_mfma_f32_16x16x32_bf16(aR, bB, drb, 0, 0, 0);
                drk = __builtin_amdgcn_mfma_f32_16x16x32_bf16(aR, bK, drk, 0, 0, 0);
            }
            asm volatile("s_waitcnt lgkmcnt(0)" ::: "memory");
#pragma unroll
            for (int r = 0; r < 4; ++r) { const int t = fq * 4 + r, s = fr;
                *(LAS float*)(tmp + (t * 16 + s) * 4) = s < t ? dab[r] : 0.f;
                *(LAS float*)(tmp + 1024 + (t * 16 + s) * 4) = s < t ? dak[r] : 0.f;
                LAS unsigned char* rb = slot + RBK_O + (((s >> 2) * 16 + t) * 8 + (s & 3)) * 2;
                const unsigned u = cvt_pk_bf16(s <= t ? drb[r] : 0.f, s <= t ? drk[r] : 0.f);
                ST_LO(rb, u); ST_HI(rb + 8, u); }
            asm volatile("s_waitcnt lgkmcnt(0)" ::: "memory");
            float Wc[16], Mc[16];
            int rotv4 = rot; asm volatile("" : "+v"(rotv4));
#pragma unroll
            for (int t = 0; t < 16; ++t) {
                float aw = at[t], am = *(const LAS float*)(tmp + 1024 + (t * 16 + fr) * 4);
#pragma unroll
                for (int s4 = 0; s4 < (t + 3) / 4; ++s4) {
                    const f32x4 row = *(const LAS f32x4*)(tmp + (t * 16 + s4 * 4) * 4);
#pragma unroll
                    for (int e = 0; e < 4; ++e) if (s4 * 4 + e < t) { aw += row[e] * Wc[s4 * 4 + e]; am += row[e] * Mc[s4 * 4 + e]; }
                }
                Wc[t] = aw; Mc[t] = am;
                { const unsigned u = cvt_pk_bf16(aw, am);
                  ST_LO(slot + WA_O + qb + (((t + rotv4) & 15) << 4), u);
                  if (lane < 16) ST_HI(slot + MAK_O + (((lane >> 2) * 16 + t) * 8 + 4 + (lane & 3)) * 2, u); }
            }
        }
        if (PROD != 2) __syncthreads();
        if (PROD == 2) {
        } else if (PROD == 1) {
            if (round + 4 < TSEQ / 128) RW_PREFETCH(round + 4);
            if (round >= 4) { if (tid == 0) sc_wait_ge(flg + 16, (unsigned)(round - 3)); __syncthreads(); }
            sc_publish_lds(p.ws + OFF_RING_R + ((size_t)bh * 4 + pj) * 8 * SLOT, 8 * SLOT);
            __syncthreads();
            if (tid == 0) sc_st(flg + pj, (unsigned)(round + 1));
            continue;
        } else if (round + 1 < TSEQ / 128) RW_PREFETCH(round + 1);
        if (wv < 4) {
            bf16x8 fa[10]; f32x4 fg[4]; u32x2 fv;
#define WLD(A_, G_, V_, j_) do { LAS unsigned char* s_ = lds + (PROD == 2 ? (round & 1) * 4 + (j_) : (j_)) * SLOT; \
                A_[0] = *(const LAS bf16x8*)(s_ + WA_O + rd0); A_[1] = *(const LAS bf16x8*)(s_ + WA_O + rd1); A_[2] = *(const LAS bf16x8*)(s_ + RT_O + rd0); A_[3] = *(const LAS bf16x8*)(s_ + RT_O + rd1); \
                A_[4] = *(const LAS bf16x8*)(s_ + MAK_O + lane * 16); A_[5] = *(const LAS bf16x8*)(s_ + RBK_O + lane * 16); \
                _Pragma("unroll") for (int kb_ = 0; kb_ < 4; ++kb_) { A_[6 + kb_] = *(const LAS bf16x8*)(s_ + KB_O + kb_ * 1024 + lane * 16); G_[kb_] = *(const LAS f32x4*)(s_ + GC_O + (kb_ * 16 + fq * 4) * 4); } \
                V_ = *(const LAS u32x2*)(s_ + VF_O + (wv * 64 + lane) * 8); } while (0)
            WLD(fa, fg, fv, 0);
#pragma unroll
            for (int j = 0; j < NJ; ++j) {
                bf16x8 na[10]; f32x4 ng[4]; u32x2 nv;
                if (j + 1 < NJ) WLD(na, ng, nv, j + 1);
                const bf16x8 sb0 = mk8(cvt_pk_bf16(Sacc[0][0], Sacc[0][1]), cvt_pk_bf16(Sacc[0][2], Sacc[0][3]), cvt_pk_bf16(Sacc[1][0], Sacc[1][1]), cvt_pk_bf16(Sacc[1][2], Sacc[1][3]));
                const bf16x8 sb1 = mk8(cvt_pk_bf16(Sacc[2][0], Sacc[2][1]), cvt_pk_bf16(Sacc[2][2], Sacc[2][3]), cvt_pk_bf16(Sacc[3][0], Sacc[3][1]), cvt_pk_bf16(Sacc[3][2], Sacc[3][3]));
                f32x4 u = {0.f, 0.f, 0.f, 0.f}, y = u;
                u = __builtin_amdgcn_mfma_f32_16x16x32_bf16(fa[0], sb0, u, 0, 0, 0);
                u = __builtin_amdgcn_mfma_f32_16x16x32_bf16(fa[1], sb1, u, 0, 0, 0);
                u = __builtin_amdgcn_mfma_f32_16x16x32_bf16(fa[4], mk8(0u, 0u, fv.x, fv.y), u, 0, 0, 0);
                y = __builtin_amdgcn_mfma_f32_16x16x32_bf16(fa[2], sb0, y, 0, 0, 0);
                y = __builtin_amdgcn_mfma_f32_16x16x32_bf16(fa[3], sb1, y, 0, 0, 0);
                const bf16x8 uv = mk8(cvt_pk_bf16(u[0], u[1]), cvt_pk_bf16(u[2], u[3]), fv.x, fv.y);
                y = __builtin_amdgcn_mfma_f32_16x16x32_bf16(fa[5], uv, y, 0, 0, 0);
#pragma unroll
                for (int kb = 0; kb < 4; ++kb) Sacc[kb] = __builtin_amdgcn_mfma_f32_16x16x32_bf16(fa[6 + kb], uv, Sacc[kb] * fg[kb], 0, 0, 0);
                { bf16_t* yo = YR + (tb + (size_t)(round * NJ + j) * 16 + fq * 4) * 1024;
                  const unsigned y01 = cvt_pk_bf16(y[0], y[1]), y23 = cvt_pk_bf16(y[2], y[3]);
                  yo[0] = (bf16_t)(y01 & 0xffffu); yo[1024] = (bf16_t)(y01 >> 16); yo[2048] = (bf16_t)(y23 & 0xffffu); yo[3072] = (bf16_t)(y23 >> 16); }
                if (j + 1 < NJ) {
#pragma unroll
                    for (int i = 0; i < 10; ++i) fa[i] = na[i];
#pragma unroll
                    for (int i = 0; i < 4; ++i) fg[i] = ng[i];
                    fv = nv;
                }
            }
#undef WLD
        }
    }
    __syncthreads();
}


__device__ void phase_scan(const Params& p) {
    if (gridDim.x >= 256) {
        const int bi = blockIdx.x;
        if (bi < 32) scan_rwkv_chunk<2>(p, bi, 0);
        else if (bi < 64) scan_hgrn_chunk<2>(p, (bi - 32) >> 1, (bi - 32) & 1);
        else if (bi < 192) scan_rwkv_chunk<1>(p, (bi - 64) >> 2, (bi - 64) & 3);
        else scan_hgrn_chunk<1>(p, (bi - 192) >> 2, (bi - 192) & 3);
    }
    __syncthreads();
}

__device__ __forceinline__ void unpack8(const u32x4 u, float (&f)[8]) {
    f[0] = bflo(u[0]); f[1] = bfhi(u[0]); f[2] = bflo(u[1]); f[3] = bfhi(u[1]); f[4] = bflo(u[2]); f[5] = bfhi(u[2]); f[6] = bflo(u[3]); f[7] = bfhi(u[3]);
}
__device__ void phase_post(const Params& p) {
    const int tid = threadIdx.x, lane = tid & 63, wv = tid >> 6;
    const bf16_t* rkvg = (const bf16_t*)(p.ws + OFF_RKVG);
    const bf16_t* YR = (const bf16_t*)(p.ws + OFF_YR);
    const bf16_t* As = (const bf16_t*)(p.ws + OFF_WINT);
    const bf16_t* YH = (const bf16_t*)(p.ws + OFF_WINT) + (size_t)NTOK * 1024;
    const bf16_t* GH = (const bf16_t*)(p.ws + OFF_GH);
    bf16_t* Y = (bf16_t*)(p.ws + OFF_F);
    for (int gw = blockIdx.x * 8 + wv; gw < 2048; gw += gridDim.x * 8) {
        const int half = gw & 1, t0 = (gw >> 1) * 8;
        {
            const int c0 = half * 512 + lane * 8;
            float mur[8], muk[8], muv[8], mug[8], cka[8], crk[8], lw[8], lb[8];
#pragma unroll
            for (int j = 0; j < 8; ++j) { mur[j] = p.mu[c0 + j]; muk[j] = p.mu[1024 + c0 + j]; muv[j] = p.mu[2048 + c0 + j]; mug[j] = p.mu[3072 + c0 + j];
                cka[j] = p.k_a[c0 + j]; crk[j] = p.r_k[c0 + j]; lw[j] = p.lnx_w[c0 + j]; lb[j] = p.lnx_b[c0 + j]; }
            const u32x4 zero4 = {0u, 0u, 0u, 0u};
            u32x4 pr = zero4, pk = zero4, pv = zero4, pg = zero4;
            if (t0 & (TSEQ - 1)) { const bf16_t* q = rkvg + (size_t)(t0 - 1) * 4096 + c0; pr = *(const u32x4*)q; pk = *(const u32x4*)(q + 1024); pv = *(const u32x4*)(q + 2048); pg = *(const u32x4*)(q + 3072); }
#pragma unroll 1
            for (int tb4 = 0; tb4 < 8; tb4 += 2) {
                u32x4 ly[2], lr[2], lk[2], lv[2], lg[2], la[2];
#pragma unroll
                for (int i = 0; i < 2; ++i) { const size_t t = t0 + tb4 + i; const bf16_t* q = rkvg + t * 4096 + c0;
                    ly[i] = *(const u32x4*)(YR + t * 1024 + c0); lr[i] = *(const u32x4*)q; lk[i] = *(const u32x4*)(q + 1024); lv[i] = *(const u32x4*)(q + 2048); lg[i] = *(const u32x4*)(q + 3072);
                    la[i] = *(const u32x4*)(As + t * 1024 + c0); }
#pragma unroll
                for (int i = 0; i < 2; ++i) { const size_t t = t0 + tb4 + i;
                    float y[8], rc[8], kc[8], vc[8], gc[8], as[8], rp[8], kp[8], vp[8], gp[8];
                    unpack8(ly[i], y); unpack8(lr[i], rc); unpack8(lk[i], kc); unpack8(lv[i], vc); unpack8(lg[i], gc); unpack8(la[i], as);
                    unpack8(pr, rp); unpack8(pk, kp); unpack8(pv, vp); unpack8(pg, gp);
                    pr = lr[i]; pk = lk[i]; pv = lv[i]; pg = lg[i];
                    float s = ((y[0] + y[1]) + (y[2] + y[3])) + ((y[4] + y[5]) + (y[6] + y[7]));
                    s += dpp_f<0xB1>(s); s += dpp_f<0x4E>(s); s += dpp_f<0x141>(s);
                    const float mean = s * (1.0f / 64.0f);
                    float q2 = 0.f, bp = 0.f, v[8], gt[8];
#pragma unroll
                    for (int j = 0; j < 8; ++j) { y[j] -= mean; q2 += y[j] * y[j];
                        const float r = rc[j] + mur[j] * (rp[j] - rc[j]), k = kc[j] + muk[j] * (kp[j] - kc[j]);
                        v[j] = vc[j] + muv[j] * (vp[j] - vc[j]); gt[j] = gc[j] + mug[j] * (gp[j] - gc[j]);
                        bp += r * (k * (1.0f + (as[j] - 1.0f) * cka[j])) * crk[j]; }
                    q2 += dpp_f<0xB1>(q2); q2 += dpp_f<0x4E>(q2); q2 += dpp_f<0x141>(q2);
                    bp += dpp_f<0xB1>(bp); bp += dpp_f<0x4E>(bp); bp += dpp_f<0x141>(bp);
                    const float rs = rsqrtf(q2 * (1.0f / 64.0f) + 64e-5f);
                    float o[8];
#pragma unroll
                    for (int j = 0; j < 8; ++j) o[j] = (y[j] * rs * lw[j] + lb[j] + bp * v[j]) * gt[j] * sigmoidf_(gt[j]);
                    const u32x4 w = {cvt_pk_bf16(o[0], o[1]), cvt_pk_bf16(o[2], o[3]), cvt_pk_bf16(o[4], o[5]), cvt_pk_bf16(o[6], o[7])};
                    *(u32x4*)(Y + t * DM + c0) = w;
                }
            }
        }
        {
            const int c0 = half * 512 + lane * 8;
            float hg[8];
#pragma unroll
            for (int j = 0; j < 8; ++j) hg[j] = p.hg[c0 + j];
#pragma unroll 1
            for (int tb4 = 0; tb4 < 8; tb4 += 4) {
                u32x4 lo[4], lg[4];
#pragma unroll
                for (int i = 0; i < 4; ++i) { const size_t t = t0 + tb4 + i; lo[i] = *(const u32x4*)(YH + t * 1024 + c0); lg[i] = *(const u32x4*)(GH + t * 1024 + c0); }
#pragma unroll
                for (int i = 0; i < 4; ++i) { const size_t t = t0 + tb4 + i;
                    float o[8], g[8]; unpack8(lo[i], o); unpack8(lg[i], g);
                    float s = 0.f;
#pragma unroll
                    for (int j = 0; j < 8; ++j) s += o[j] * o[j];
                    s = allred16(s);
                    const float rs = rsqrtf(s * (1.0f / 128.0f) + 1e-6f);
#pragma unroll
                    for (int j = 0; j < 8; ++j) o[j] = o[j] * rs * hg[j] * g[j];
                    const u32x4 w = {cvt_pk_bf16(o[0], o[1]), cvt_pk_bf16(o[2], o[3]), cvt_pk_bf16(o[4], o[5]), cvt_pk_bf16(o[6], o[7])};
                    *(u32x4*)(Y + t * DM + 1024 + c0) = w;
                }
            }
        }
    }
}

#ifndef DUP_PHASE
#define DUP_PHASE -1
#endif
#define RUN_PHASE(N, CALL) do { if (ph_lo <= (N) && (N) <= ph_hi) { if (ph_lo < (N)) xcd_barrier(xb); CALL; if ((N) == DUP_PHASE) { xcd_barrier(xb); CALL; } } } while (0)
__global__ void __launch_bounds__(512, 2) fwd_megakernel(Params p, int ph_lo, int ph_hi) {
    cg::grid_group grid = cg::this_grid();
    if (ph_lo < 0) grid.sync();
    volatile LAS unsigned* st = (volatile LAS unsigned*)((LAS unsigned char*)smem_raw + LDS_ST);
    if (threadIdx.x == 0) { st[0] = 0u; st[1] = 0u; st[2] = 0u; st[3] = 0u; }
    __syncthreads();
    const XcdBarrier xb = xcd_barrier_post(p.bar, st);
    RUN_PHASE(0, phase_prep0(p));
    RUN_PHASE(1, phase_gemm1(p));
    RUN_PHASE(2, phase_lora_in(p));
    RUN_PHASE(3, phase_gemm_lora(p));
    RUN_PHASE(4, phase_scan(p));
    RUN_PHASE(5, phase_post(p));
    RUN_PHASE(6, phase_gemm2(p));
}

extern "C" void kernel_launch(void* const* d_in, const int* in_sizes, int n_in, void* d_out, int out_size, void* d_ws, size_t ws_size, hipStream_t stream) {
    static int grid_blocks = 0;
    if (!grid_blocks) {
        int dev = 0, cus = 0, per_cu = 0;
        hipGetDevice(&dev);
        hipDeviceGetAttribute(&cus, hipDeviceAttributeMultiprocessorCount, dev);
        hipFuncSetAttribute((const void*)fwd_megakernel, hipFuncAttributeMaxDynamicSharedMemorySize, LDS_BYTES);
        hipOccupancyMaxActiveBlocksPerMultiprocessor(&per_cu, fwd_megakernel, 512, LDS_BYTES);
        if (per_cu < 1) per_cu = 1;
        grid_blocks = cus * per_cu;
        if (grid_blocks > 256) grid_blocks = 256;
    }
    if (ws_size < WS_END) { fprintf(stderr, "workspace too small: %zu < %zu\n", ws_size, (size_t)WS_END); return; }
    Params p{};
    p.x = (const float*)d_in[0]; p.norm_g = (const float*)d_in[1]; p.w_in = (const float*)d_in[2]; p.mu = (const float*)d_in[3];
    p.w0 = (const float*)d_in[4]; p.w2 = (const float*)d_in[5]; p.a0 = (const float*)d_in[6]; p.a2 = (const float*)d_in[7];
    p.k_k = (const float*)d_in[8]; p.k_a = (const float*)d_in[9]; p.r_k = (const float*)d_in[10]; p.lnx_w = (const float*)d_in[11];
    p.lnx_b = (const float*)d_in[12]; p.hg = (const float*)d_in[13]; p.lbp = (const float*)d_in[14]; p.w_out = (const float*)d_in[15];
    p.final_g = (const float*)d_in[16];
    p.out = (float*)d_out; p.ws = (unsigned char*)d_ws; p.bar = (unsigned*)((unsigned char*)d_ws + OFF_BAR);
    hipMemsetAsync((unsigned char*)d_ws + OFF_BAR, 0, 32768, stream);
#if MK_SINGLE
    int lo = 0, hi = 6;
    void* args[] = {&p, &lo, &hi};
    hipError_t e = hipLaunchCooperativeKernel((const void*)fwd_megakernel, dim3(grid_blocks), dim3(512), args, LDS_BYTES, stream);
    if (e != hipSuccess) fprintf(stderr, "cooperative launch failed: %s (grid %d)\n", hipGetErrorString(e), grid_blocks);
#else
    for (int ph = 0; ph <= 6; ++ph) fwd_megakernel<<<dim3(grid_blocks), dim3(512), LDS_BYTES, stream>>>(p, ph, ph);
#endif
}
```

```cpp
#include <hip/hip_runtime.h>
#include <hip/hip_cooperative_groups.h>
#include <cstdio>
#include <cstdint>
namespace cg = cooperative_groups;

#ifndef MK_SINGLE
#define MK_SINGLE 1
#endif

typedef unsigned short bf16_t;
using bf16x8 = __attribute__((ext_vector_type(8))) short;
using f32x4 = __attribute__((ext_vector_type(4))) float;
using u32x2 = __attribute__((ext_vector_type(2))) unsigned;
using u32x4 = __attribute__((ext_vector_type(4))) unsigned;

constexpr int NTOK = 8192, TSEQ = 4096, DM = 2048, NINP = 8448;
constexpr int BM = 256, BK = 64, HALF = 128, NXCD = 8, WGM = 8, HT = HALF * BK, SHM_B = 8 * HT * 2;

constexpr int LDS_ST = 149504, LDS_BYTES = LDS_ST + 32;
constexpr size_t OFF_HN = 0;
constexpr size_t OFF_WINT = 33554432;
constexpr size_t OFF_WOUTT = OFF_WINT + 34603008;
constexpr size_t OFF_Q = OFF_WOUTT + 8388608;
constexpr size_t OFF_F = OFF_Q + 16777216;
constexpr size_t OFF_I = OFF_F + 33554432;
constexpr size_t OFF_GH = OFF_I + 16777216;
constexpr size_t OFF_RKVG = OFF_GH + 16777216;
constexpr size_t OFF_WDAD = OFF_RKVG + 67108864;
constexpr size_t OFF_YR = OFF_WDAD + 8388608;
constexpr size_t OFF_SC = OFF_YR + 16777216;
constexpr size_t OFF_LA = OFF_SC + 524288;
constexpr size_t OFF_LB = OFF_LA + 4194304;
constexpr size_t OFF_WP3 = OFF_LB + 1048576;
constexpr size_t OFF_BAR = OFF_WP3 + 8388608;
constexpr size_t OFF_FLG = OFF_BAR + 16384;
constexpr size_t OFF_LBV = OFF_FLG + 16384;
constexpr size_t WS_END = OFF_LBV + 4096;
constexpr size_t OFF_RING_R = OFF_LA;
constexpr size_t OFF_RING_H = OFF_WDAD;
static_assert(OFF_RING_R + (size_t)32 * 4 * 8 * 12544 <= OFF_BAR, "RWKV ring overruns");
static_assert((size_t)16 * 4 * 8 * 13824 <= 8388608, "HGRN ring overruns");
__host__ __device__ constexpr size_t wp_off(int ks) { return ks == 0 ? OFF_WDAD : (ks == 1 ? OFF_YR : (ks == 2 ? OFF_YR + 8388608 : OFF_WP3)); }

struct Params {
    const float* x; const float* norm_g; const float* w_in; const float* mu; const float* w0; const float* w2;
    const float* a0; const float* a2; const float* k_k; const float* k_a; const float* r_k; const float* lnx_w;
    const float* lnx_b; const float* hg; const float* lbp; const float* w_out; const float* final_g;
    float* out; unsigned char* ws; unsigned* bar;
};

extern __shared__ __attribute__((aligned(16))) unsigned char smem_raw[];

__device__ __forceinline__ bf16_t f2bf(float f) { unsigned u = __float_as_uint(f); u += 0x7fffu + ((u >> 16) & 1u); return (bf16_t)(u >> 16); }
__device__ __forceinline__ float bf2f(bf16_t h) { return __uint_as_float(((unsigned)h) << 16); }
typedef float f32x2_t __attribute__((ext_vector_type(2)));
typedef __bf16 bf16x2_t __attribute__((ext_vector_type(2)));
__device__ __forceinline__ unsigned cvt_pk_bf16(float lo, float hi) { const f32x2_t v = {lo, hi}; const bf16x2_t b = __builtin_convertvector(v, bf16x2_t); return __builtin_bit_cast(unsigned, b); }
__device__ __forceinline__ unsigned pack2(float a, float b) { return cvt_pk_bf16(a, b); }
__device__ __forceinline__ float wave_sum(float v) {
#pragma unroll
    for (int o = 32; o > 0; o >>= 1) v += __shfl_xor(v, o);
    return v;
}
template <int CTRL> __device__ __forceinline__ float dpp_f(float v) {
    return __int_as_float(__builtin_amdgcn_update_dpp(0, __float_as_int(v), CTRL, 0xf, 0xf, false));
}
__device__ __forceinline__ float allred16(float v) {
    v += dpp_f<0xB1>(v);
    v += dpp_f<0x4E>(v);
    v += dpp_f<0x124>(v);
    v += dpp_f<0x128>(v);
    return v;
}
typedef __attribute__((address_space(1))) unsigned gu32;
typedef __attribute__((address_space(1))) unsigned long long gu64;
typedef __attribute__((address_space(1))) float gf32;
#define SC_SPIN_CAP (1u << 22)
__device__ __forceinline__ unsigned sc_ld(unsigned* p) { return __hip_atomic_load((gu32*)p, __ATOMIC_RELAXED, __HIP_MEMORY_SCOPE_AGENT); }
__device__ __forceinline__ void sc_st(unsigned* p, unsigned v) { __hip_atomic_store((gu32*)p, v, __ATOMIC_RELAXED, __HIP_MEMORY_SCOPE_AGENT); }
__device__ __forceinline__ float sc_ldf(float* p) { return __hip_atomic_load((gf32*)p, __ATOMIC_RELAXED, __HIP_MEMORY_SCOPE_AGENT); }
__device__ __forceinline__ void sc_stf(float* p, float v) { __hip_atomic_store((gf32*)p, v, __ATOMIC_RELAXED, __HIP_MEMORY_SCOPE_AGENT); }
__device__ __forceinline__ void sc_wait_ge(unsigned* p, unsigned v) { unsigned sp = 0; while (sc_ld(p) < v) { __builtin_amdgcn_s_sleep(2); if (++sp > SC_SPIN_CAP) break; } }
__device__ __forceinline__ float sigmoidf_(float x) { return __builtin_amdgcn_rcpf(1.0f + __expf(-x)); }


#define LAS __attribute__((address_space(3)))
#define XB_TMO      128
#define XB_XCNT(j)  (256  + 64 * (j))
#define XB_XSUB(j)  (1280 + 64 * (j))
#define XB_XGEN(j)  (2304 + 64 * (j))
#define XB_TOP      3328
#define XB_TOPGEN   3392
#define XCD_BAR_WORDS 3456
#define XB_SPIN_CAP (1u << 18)
__device__ __forceinline__ unsigned xb_ld(unsigned* p)              { return __hip_atomic_load(p, __ATOMIC_RELAXED, __HIP_MEMORY_SCOPE_AGENT); }
__device__ __forceinline__ unsigned xb_add(unsigned* p, unsigned v) { return __hip_atomic_fetch_add(p, v, __ATOMIC_RELAXED, __HIP_MEMORY_SCOPE_AGENT); }
__device__ __forceinline__ unsigned xb_xcc_id() { return (unsigned)__builtin_amdgcn_s_getreg((3 << 11) | 20) & 0xFu; }
#define XB_SPIN(cond, bar) do { unsigned _sp = 0; while (cond) { __builtin_amdgcn_s_sleep(1); \
    if ((++_sp & 255u) == 0u) { if (xb_ld(&(bar)[XB_TMO])) break; if (_sp > XB_SPIN_CAP) { atomicAdd(&(bar)[XB_TMO], 1u); break; } } } } while (0)
struct XcdBarrier { unsigned* bar; unsigned x; volatile LAS unsigned* st; };
__device__ __forceinline__ XcdBarrier xcd_barrier_post(unsigned* bar, volatile LAS unsigned* st) {
    XcdBarrier b; b.bar = bar; b.x = xb_xcc_id(); b.st = st;
    if (threadIdx.x == 0) (void)xb_add(&bar[XB_XCNT(b.x)], 1u);
    return b;
}
__device__ __forceinline__ void xcd_barrier_complete(unsigned* bar, unsigned x, unsigned& nloc, unsigned& nx) {
    const unsigned G = gridDim.x * gridDim.y * gridDim.z;
    unsigned sum, cnt, mine, sp = 0u;
    for (;;) {
        sum = 0u; cnt = 0u; mine = 0u;
#pragma unroll
        for (unsigned j = 0; j < 16; ++j) { const unsigned c = xb_ld(&bar[XB_XCNT(j)]); sum += c; cnt += (c > 0u) ? 1u : 0u; mine = (j == x) ? c : mine; }
        if (sum == G) break;
        __builtin_amdgcn_s_sleep(1);
        if ((++sp & 255u) == 0u) { if (xb_ld(&bar[XB_TMO])) break; if (sp > XB_SPIN_CAP) { atomicAdd(&bar[XB_TMO], 1u); break; } }
    }
    nloc = mine > 0u ? mine : 1u; nx = cnt > 0u ? cnt : 1u;
}
__device__ __forceinline__ void xcd_barrier(const XcdBarrier& b) {
    asm volatile("s_waitcnt vmcnt(0)" ::: "memory");
    __syncthreads();
    if (threadIdx.x == 0) {
        unsigned* bar = b.bar;
        __builtin_amdgcn_s_waitcnt(0);
        unsigned nloc = b.st[0], nx = b.st[1];
        if (nloc == 0u) { xcd_barrier_complete(bar, b.x, nloc, nx); b.st[0] = nloc; b.st[1] = nx; }
        const unsigned old = xb_add(&bar[XB_XSUB(b.x)], 1u);
        const unsigned gen = old / nloc;
        if (old + 1u == (gen + 1u) * nloc) {
            __builtin_amdgcn_fence(__ATOMIC_RELEASE, "agent");
            asm volatile("s_waitcnt vmcnt(0)" ::: "memory");
            const unsigned og = xb_add(&bar[XB_TOP], 1u);
            const unsigned tg = og / nx;
            if (og + 1u == (tg + 1u) * nx) xb_add(&bar[XB_TOPGEN], 1u);
            else XB_SPIN(xb_ld(&bar[XB_TOPGEN]) == tg, bar);
            __builtin_amdgcn_fence(__ATOMIC_ACQUIRE, "agent");
            xb_add(&bar[XB_XGEN(b.x)], 1u);
            asm volatile("s_waitcnt vmcnt(0)" ::: "memory");
        } else {
            XB_SPIN(xb_ld(&bar[XB_XGEN(b.x)]) == gen, bar);
            __builtin_amdgcn_fence(__ATOMIC_ACQUIRE, "agent");
            asm volatile("s_waitcnt vmcnt(0)" ::: "memory");
        }
    }
    __syncthreads();
}

__device__ __forceinline__ int lds_byte(int r, int c) {
    int st = (r >> 4) * 2 + (c >> 5), rr = r & 15, cc = c & 31, ob = rr * 64 + cc * 2;
    return st * 1024 + (ob ^ (((ob >> 9) & 1) << 5));
}
__device__ __forceinline__ void stage_rc(int b, int& R, int& C) {
    int st = b / 1024, sb = b % 1024, swz = sb ^ (((sb >> 9) & 1) << 5);
    R = (st >> 1) * 16 + swz / 64; C = (st & 1) * 32 + (swz % 64) / 2;
}
__device__ __forceinline__ void unit_of(int L, int nM, int nN, int& pm, int& pn) {
    const int nwg = nM * nN; int wgid = L;
    { const int q = nwg / NXCD, r = nwg % NXCD, xcd = wgid % NXCD, off = wgid / NXCD; wgid = (xcd < r ? xcd * (q + 1) : r * (q + 1) + (xcd - r) * q) + off; }
    const int nig = WGM * nN, gid = wgid / nig, fm = gid * WGM, gsz = (nM - fm) < WGM ? (nM - fm) : WGM;
    pm = fm + ((wgid % nig) % gsz); pn = (wgid % nig) / gsz;
}

template <class Epi>
__device__ __forceinline__ void gemm_tile(const bf16_t* __restrict__ gA, const bf16_t* __restrict__ gB, const int K  , const int kbeg, const int nt  , const int pm, const int pn, const Epi& epi) {
    LAS unsigned char* lds = (LAS unsigned char*)smem_raw;
    constexpr int HTB = HT * 2;
    const int tid = threadIdx.x, wid = __builtin_amdgcn_readfirstlane(tid >> 6), lane = tid & 63, wr = wid >> 2, wc = wid & 3, fr = lane & 15, fq = lane >> 4;
    unsigned voff[2], voffB[2];
#pragma unroll
    for (int i = 0; i < 2; ++i) { int R, C; stage_rc(tid * 16 + i * 8192, R, C); voff[i] = (unsigned)(R * K + C) * 2u;
        const int rho = R & 31, Rb = (R & ~31) + 8 * ((rho & 15) >> 2) + 4 * (rho >> 4) + (rho & 3); voffB[i] = (unsigned)(Rb * K + C) * 2u; }
    const size_t kstep = (size_t)(BK * 2), hstep = (size_t)HALF * K * 2, tstep = 2 * hstep;
    const unsigned ldsw = (unsigned)wid * 1024u;
    const int aoff = lds_byte(wr * 64 + fr, fq * 8), boff = lds_byte(wc * 32 + fr, fq * 8);
    const char* cA = (const char*)gA + (size_t)pm * tstep + (size_t)kbeg * 2; const char* cB = (const char*)gB + (size_t)pn * tstep + (size_t)kbeg * 2;
#define SA(b, h) (((b) * 2 + (h)) * HTB)
#define SB(b, h) ((4 + (b) * 2 + (h)) * HTB)
#define STAGE(bufoff, gbase) do { _Pragma("unroll") for (int _i = 0; _i < 2; ++_i) \
    __builtin_amdgcn_global_load_lds((const unsigned*)((const char*)(gbase) + voff[_i]), (LAS unsigned*)(lds + (bufoff) + ldsw + _i * 8192), 16, 0, 0); } while (0)
#define STAGEB(bufoff, gbase) do { _Pragma("unroll") for (int _i = 0; _i < 2; ++_i) \
    __builtin_amdgcn_global_load_lds((const unsigned*)((const char*)(gbase) + voffB[_i]), (LAS unsigned*)(lds + (bufoff) + ldsw + _i * 8192), 16, 0, 0); } while (0)
#define LDA(dst, b, h) do { _Pragma("unroll") for (int m = 0; m < 4; ++m) _Pragma("unroll") for (int k = 0; k < 2; ++k) dst[m][k] = *(const LAS bf16x8*)(lds + SA(b, h) + aoff + m * 2048 + k * 1024); } while (0)
#define LDB(dst, b, h) do { _Pragma("unroll") for (int n = 0; n < 2; ++n) _Pragma("unroll") for (int k = 0; k < 2; ++k) dst[n][k] = *(const LAS bf16x8*)(lds + SB(b, h) + boff + n * 2048 + k * 1024); } while (0)
#define MMA(ai, bj, AT, BT) do { __builtin_amdgcn_s_setprio(1); _Pragma("unroll") for (int m = 0; m < 4; ++m) _Pragma("unroll") for (int n = 0; n < 2; ++n) _Pragma("unroll") for (int k = 0; k < 2; ++k) \
      acc[ai][bj][m][n] = __builtin_amdgcn_mfma_f32_16x16x32_bf16(BT[n][k], AT[m][k], acc[ai][bj][m][n], 0, 0, 0); \
    __builtin_amdgcn_s_setprio(0); } while (0)
#define WAIT_V(n) asm volatile("s_waitcnt vmcnt(" #n ")" ::: "memory")
#define WAIT_L(n) asm volatile("s_waitcnt lgkmcnt(" #n ")" ::: "memory")
#define BAR __builtin_amdgcn_s_barrier()
#define SCHED __builtin_amdgcn_sched_barrier(0)
    f32x4 acc[2][2][4][2];
#pragma unroll
    for (int a = 0; a < 2; ++a)
#pragma unroll
        for (int b = 0; b < 2; ++b)
#pragma unroll
            for (int m = 0; m < 4; ++m)
#pragma unroll
                for (int n = 0; n < 2; ++n) acc[a][b][m][n] = (f32x4){0.f, 0.f, 0.f, 0.f};
    bf16x8 At[4][2], B0[2][2], B1[2][2];
    STAGEB(SB(0, 0), cB); STAGE(SA(0, 0), cA); STAGEB(SB(0, 1), cB + hstep); STAGE(SA(0, 1), cA + hstep);
    if (wr == 1) BAR;
    WAIT_V(4); BAR;
    STAGEB(SB(1, 0), cB + kstep); STAGE(SA(1, 0), cA + kstep); STAGEB(SB(1, 1), cB + hstep + kstep);
    WAIT_V(6); BAR;
    for (int t = 0; t < nt - 2; t += 2) {
        const char* a1 = cA + (size_t)(t + 1) * kstep;
        const char* a2 = cA + (size_t)(t + 2) * kstep; const char* b2 = cB + (size_t)(t + 2) * kstep;
        const char* a3 = a2 + kstep; const char* b3 = b2 + kstep;
        LDB(B0, 0, 0); SCHED; LDA(At, 0, 0); STAGE(SA(1, 1), a1 + hstep);
        WAIT_L(8); BAR; WAIT_L(0); MMA(0, 0, At, B0); BAR; SCHED;
        LDB(B1, 0, 1); STAGEB(SB(0, 0), b2);
        BAR; WAIT_L(0); MMA(0, 1, At, B1); BAR;
        LDA(At, 0, 1); STAGE(SA(0, 0), a2);
        BAR; WAIT_L(0); MMA(1, 0, At, B0); BAR; SCHED;
        STAGEB(SB(0, 1), b2 + hstep);
        WAIT_V(6); BAR; MMA(1, 1, At, B1); BAR;
        LDB(B0, 1, 0); SCHED; LDA(At, 1, 0); STAGE(SA(0, 1), a2 + hstep);
        WAIT_L(8); BAR; WAIT_L(0); MMA(0, 0, At, B0); BAR; SCHED;
        LDB(B1, 1, 1); STAGEB(SB(1, 0), b3);
        BAR; WAIT_L(0); MMA(0, 1, At, B1); BAR;
        LDA(At, 1, 1); STAGE(SA(1, 0), a3);
        BAR; WAIT_L(0); MMA(1, 0, At, B0); BAR; SCHED;
        STAGEB(SB(1, 1), b3 + hstep);
        WAIT_V(6); BAR; MMA(1, 1, At, B1); BAR;
    }
    { const char* aL = cA + (size_t)(nt - 1) * kstep;
      LDB(B0, 0, 0); LDA(At, 0, 0); STAGE(SA(1, 1), aL + hstep);
      BAR; WAIT_L(0); MMA(0, 0, At, B0); BAR;
      LDB(B1, 0, 1); BAR; WAIT_L(0); MMA(0, 1, At, B1); BAR;
      LDA(At, 0, 1); WAIT_V(4); BAR; WAIT_L(0); MMA(1, 0, At, B0); MMA(1, 1, At, B1); BAR; }
    { LDB(B0, 1, 0); LDA(At, 1, 0); WAIT_V(2); BAR; WAIT_L(0); MMA(0, 0, At, B0); BAR;
      LDB(B1, 1, 1); WAIT_V(0); BAR; WAIT_L(0); MMA(0, 1, At, B1); BAR;
      LDA(At, 1, 1); BAR; WAIT_L(0); MMA(1, 0, At, B0); MMA(1, 1, At, B1); BAR; }
    if (wr == 0) BAR;
    if constexpr (Epi::FUSED) { __syncthreads(); epi.fused(acc, pm, pn, wr, wc, fr, fq); __syncthreads(); return; }
    const int brow = pm * BM;
#pragma unroll
    for (int ai = 0; ai < 2; ++ai)
#pragma unroll
        for (int m = 0; m < 4; ++m) {
#pragma unroll
            for (int bj = 0; bj < 2; ++bj)
                epi(acc[ai][bj][m][0], acc[ai][bj][m][1], brow + ai * HALF + wr * 64 + m * 16 + fr, bj * HALF + wc * 32 + fq * 8, pn);
            asm volatile("" ::: "memory");
        }
    __syncthreads();
#undef SA
#undef SB
#undef STAGE
#undef STAGEB
#undef LDA
#undef LDB
#undef MMA
}

struct Epi1 {
    static constexpr bool FUSED = false;
    unsigned char* ws; const float* lbp;
    __device__ __forceinline__ void operator()(const f32x4& v0, const f32x4& v1, int row, int cl, int pn) const {
        if (pn < 16) {
            const int sec = pn >> 2, c = (pn & 3) * 256 + cl;
            if (sec == 1) {
                f32x4 o0, o1;
                const f32x4 l0 = *(const f32x4*)(lbp + c), l1 = *(const f32x4*)(lbp + c + 4);
#pragma unroll
                for (int j = 0; j < 4; ++j) { o0[j] = l0[j] + (1.0f - l0[j]) * sigmoidf_(v0[j]); o1[j] = l1[j] + (1.0f - l1[j]) * sigmoidf_(v1[j]); }
                float* d = (float*)(ws + OFF_F) + (size_t)row * 1024 + c;
                *(f32x4*)d = o0; *(f32x4*)(d + 4) = o1;
            } else {
                bf16_t* dst = (bf16_t*)(ws + (sec == 0 ? OFF_Q : (sec == 2 ? OFF_I : OFF_GH))) + (size_t)row * 1024 + c;
                f32x4 o0 = v0, o1 = v1;
                if (sec == 3) {
#pragma unroll
                    for (int j = 0; j < 4; ++j) { o0[j] = v0[j] * sigmoidf_(v0[j]); o1[j] = v1[j] * sigmoidf_(v1[j]); }
                }
                uint4 w; w.x = pack2(o0[0], o0[1]); w.y = pack2(o0[2], o0[3]); w.z = pack2(o1[0], o1[1]); w.w = pack2(o1[2], o1[3]);
                *(uint4*)dst = w;
            }
        } else {
            bf16_t* dst = (bf16_t*)(ws + OFF_RKVG) + (size_t)row * 4096 + (pn - 16) * 256 + cl;
            uint4 w; w.x = pack2(v0[0], v0[1]); w.y = pack2(v0[2], v0[3]); w.z = pack2(v1[0], v1[1]); w.w = pack2(v1[2], v1[3]);
            *(uint4*)dst = w;
        }
    }
};
struct EpiPart {
    static constexpr bool FUSED = false;
    float* dst;
    __device__ __forceinline__ void operator()(const f32x4& v0, const f32x4& v1, int row, int cl, int pn) const {
        float* d = dst + (size_t)row * 256 + cl;
        *(f32x4*)d = v0; *(f32x4*)(d + 4) = v1;
    }
};
struct Epi2 {
    static constexpr bool FUSED = true;
    const float* x; float* out; const float* g; float* part; unsigned* cnt;
    __device__ __forceinline__ void fused(f32x4 (&acc)[2][2][4][2], int pm, int pn, int wr, int wc, int fr, int fq) const {
        LAS float* ssum = (LAS float*)smem_raw;
        LAS float* rsl = ssum + 1024;
        const int tid = threadIdx.x;
#pragma unroll
        for (int ai = 0; ai < 2; ++ai)
#pragma unroll
            for (int m = 0; m < 4; ++m) {
                const int r = ai * HALF + wr * 64 + m * 16 + fr; float s = 0.f;
#pragma unroll
                for (int bj = 0; bj < 2; ++bj)
#pragma unroll
                    for (int n = 0; n < 2; ++n) {
                        const f32x4 xv = *(const f32x4*)(x + (size_t)(pm * BM + r) * DM + pn * BM + bj * HALF + wc * 32 + fq * 8 + n * 4);
                        const f32x4 hv = acc[ai][bj][m][n] + xv; acc[ai][bj][m][n] = hv;
                        s += hv[0] * hv[0] + hv[1] * hv[1] + hv[2] * hv[2] + hv[3] * hv[3];
                    }
                s += __shfl_xor(s, 16); s += __shfl_xor(s, 32);
                if (fq == 0) ssum[r * 4 + wc] = s;
            }
        __syncthreads();
        if (tid < 256) sc_stf(part + (size_t)(pm * 8 + pn) * 256 + tid, (ssum[tid * 4] + ssum[tid * 4 + 1]) + (ssum[tid * 4 + 2] + ssum[tid * 4 + 3]));
        asm volatile("s_waitcnt vmcnt(0)" ::: "memory");
        __syncthreads();
        if (tid == 0) { __hip_atomic_fetch_add((gu32*)(cnt + pm * 16), 1u, __ATOMIC_RELAXED, __HIP_MEMORY_SCOPE_AGENT); sc_wait_ge(cnt + pm * 16, 8u); }
        __syncthreads();
        __builtin_amdgcn_fence(__ATOMIC_ACQUIRE, "agent");
        if (tid < 256) { float t = 0.f;
#pragma unroll
            for (int q = 0; q < 8; ++q) t += sc_ldf(part + (size_t)(pm * 8 + q) * 256 + tid);
            rsl[tid] = rsqrtf(t * (1.0f / DM) + 1e-6f); }
        __syncthreads();
#pragma unroll
        for (int ai = 0; ai < 2; ++ai)
#pragma unroll
            for (int m = 0; m < 4; ++m) {
                const int r = ai * HALF + wr * 64 + m * 16 + fr; const float rs = rsl[r];
#pragma unroll
                for (int bj = 0; bj < 2; ++bj)
#pragma unroll
                    for (int n = 0; n < 2; ++n) {
                        const int c = pn * BM + bj * HALF + wc * 32 + fq * 8 + n * 4;
                        const f32x4 gv = *(const f32x4*)(g + c);
                        *(f32x4*)(out + (size_t)(pm * BM + r) * DM + c) = acc[ai][bj][m][n] * rs * gv;
                    }
            }
    }
    __device__ __forceinline__ void operator()(const f32x4& v0, const f32x4& v1, int row, int cl, int pn) const {}
};
struct Epi3 {
    static constexpr bool FUSED = false;
    unsigned char* ws; const float* w0; const float* a0;
    __device__ __forceinline__ void operator()(const f32x4& v0, const f32x4& v1, int row, int cl, int pn) const {
        if (pn < 4) {
            const int c = pn * 256 + cl; const f32x4 b0 = *(const f32x4*)(w0 + c), b1 = *(const f32x4*)(w0 + c + 4); f32x4 o0, o1;
#pragma unroll
            for (int j = 0; j < 4; ++j) { o0[j] = __expf(-0.6065306597126334f * sigmoidf_(b0[j] + v0[j])); o1[j] = __expf(-0.6065306597126334f * sigmoidf_(b1[j] + v1[j])); }
            float* d = (float*)(ws + OFF_HN) + (size_t)row * 1024 + c;
            *(f32x4*)d = o0; *(f32x4*)(d + 4) = o1;
        } else {
            const int c = (pn - 4) * 256 + cl; const f32x4 b0 = *(const f32x4*)(a0 + c), b1 = *(const f32x4*)(a0 + c + 4);
            uint4 w; w.x = pack2(sigmoidf_(b0[0] + v0[0]), sigmoidf_(b0[1] + v0[1])); w.y = pack2(sigmoidf_(b0[2] + v0[2]), sigmoidf_(b0[3] + v0[3]));
            w.z = pack2(sigmoidf_(b1[0] + v1[0]), sigmoidf_(b1[1] + v1[1])); w.w = pack2(sigmoidf_(b1[2] + v1[2]), sigmoidf_(b1[3] + v1[3]));
            *(uint4*)((bf16_t*)(ws + OFF_WINT) + (size_t)row * 1024 + c) = w;
        }
    }
};

__device__ void build_lora_weights(const Params& p, int first, int stride) {
    bf16_t* lb = (bf16_t*)(p.ws + OFF_LB);
    for (int i = first; i < 2048 * 32; i += stride) {
        const int n = i >> 5, k0 = (i & 31) * 8; float e[8];
#pragma unroll
        for (int j = 0; j < 8; ++j) { const int k = k0 + j; float val = 0.f;
            if (n < 1024) { if (k < 96) val = p.w2[k * 1024 + n]; } else { if (k >= 128 && k < 224) val = p.a2[(k - 128) * 1024 + (n - 1024)]; }
            e[j] = val; }
        uint4 w; w.x = pack2(e[0], e[1]); w.y = pack2(e[2], e[3]); w.z = pack2(e[4], e[5]); w.w = pack2(e[6], e[7]);
        *(uint4*)(lb + (size_t)n * 256 + k0) = w;
    }
}
__device__ void prep_tiles(const Params& p, int t_begin, int t_end, int first, int stride) {
    const int tid = threadIdx.x;
    float* tile = (float*)smem_raw;
    bf16_t* wint = (bf16_t*)(p.ws + OFF_WINT);
    bf16_t* woutt = (bf16_t*)(p.ws + OFF_WOUTT);
    constexpr int NT1 = 132 * 32;
    const int lr = tid >> 4, lc = (tid & 15) * 4;
    f32x4 ld0, ld1; const f32x4 zero4 = {0.f, 0.f, 0.f, 0.f};
#define TR_DECODE(tl_) const float* src; int ld, c0; bf16_t* dst; int kt; \
        if ((tl_) < NT1) { const int ntile = (tl_) >> 5; kt = (tl_) & 31; const int n0 = ntile * 64; \
            c0 = n0 < 4096 ? 4288 + n0 : (n0 < 8192 ? n0 - 4096 : (n0 < 8384 ? 4096 + (n0 - 8192) : -1)); \
            src = p.w_in; ld = 8384; dst = wint + (size_t)n0 * DM; } \
        else { const int u = (tl_) - NT1; const int ntile = u >> 5; kt = u & 31; c0 = ntile * 64; src = p.w_out; ld = DM; dst = woutt + (size_t)ntile * 64 * DM; } \
        const int k0 = kt * 64;
#define TR_LOAD(tl_) do { TR_DECODE(tl_) (void)dst; \
        ld0 = c0 >= 0 ? *(const f32x4*)(src + (size_t)(k0 + lr) * ld + c0 + lc) : zero4; \
        ld1 = c0 >= 0 ? *(const f32x4*)(src + (size_t)(k0 + lr + 32) * ld + c0 + lc) : zero4; } while (0)
    if (t_begin + first < t_end) TR_LOAD(t_begin + first);
    for (int tl = t_begin + first; tl < t_end; tl += stride) {
        __syncthreads();
#pragma unroll
        for (int j = 0; j < 4; ++j) { tile[lr * 65 + lc + j] = ld0[j]; tile[(lr + 32) * 65 + lc + j] = ld1[j]; }
        __syncthreads();
        if (tl + stride < t_end) TR_LOAD(tl + stride);
        TR_DECODE(tl) (void)src; (void)ld; (void)c0;
        const int n = tid >> 3, ks = tid & 7;
        float e[8];
#pragma unroll
        for (int j = 0; j < 8; ++j) e[j] = tile[(ks * 8 + j) * 65 + n];
        uint4 w; w.x = pack2(e[0], e[1]); w.y = pack2(e[2], e[3]); w.z = pack2(e[4], e[5]); w.w = pack2(e[6], e[7]);
        *(uint4*)(dst + (size_t)n * DM + k0 + ks * 8) = w;
    }
#undef TR_LOAD
#undef TR_DECODE
    __syncthreads();
}

__device__ void phase_prep0(const Params& p) {
    const int tid = threadIdx.x, lane = tid & 63, wv = tid >> 6;
    const int gw = blockIdx.x * 8 + wv, nw = gridDim.x * 8;
    bf16_t* hn = (bf16_t*)(p.ws + OFF_HN);
    for (int row = gw; row < NTOK; row += nw) {
        const f32x4* xr = (const f32x4*)(p.x + (size_t)row * DM);
        f32x4 v[8]; float ss = 0.f;
#pragma unroll
        for (int i = 0; i < 8; ++i) { v[i] = xr[i * 64 + lane]; ss += v[i][0] * v[i][0] + v[i][1] * v[i][1] + v[i][2] * v[i][2] + v[i][3] * v[i][3]; }
        ss = wave_sum(ss);
        const float rs = rsqrtf(ss * (1.0f / DM) + 1e-6f);
#pragma unroll
        for (int i = 0; i < 8; ++i) {
            const f32x4 g = ((const f32x4*)p.norm_g)[i * 64 + lane];
            uint2 w; w.x = pack2(v[i][0] * rs * g[0], v[i][1] * rs * g[1]); w.y = pack2(v[i][2] * rs * g[2], v[i][3] * rs * g[3]);
            *(uint2*)(hn + (size_t)row * DM + (i * 64 + lane) * 4) = w;
        }
    }
    { const int i = blockIdx.x * 512 + tid; if (i < 1024) ((float*)(p.ws + OFF_LBV))[i] = sigmoidf_(p.lbp[i] - p.lbp[1024 + i]); }
    prep_tiles(p, 0, 132 * 32, blockIdx.x, gridDim.x);
}

__device__ void phase_gemm1(const Params& p) {
    const bf16_t* A = (const bf16_t*)(p.ws + OFF_HN);
    const bf16_t* B = (const bf16_t*)(p.ws + OFF_WINT);
    Epi1 epi{p.ws, (const float*)(p.ws + OFF_LBV)};
    for (int L = blockIdx.x; L < 32 * 32; L += gridDim.x) { int pm, pn; unit_of(L, 32, 32, pm, pn); gemm_tile(A, B, DM, 0, DM / BK, pm, pn, epi); }
    for (int it = blockIdx.x; it < 128; it += gridDim.x) { const int ks = it & 3; EpiPart ep{(float*)(p.ws + wp_off(ks))}; gemm_tile(A, B, DM, ks * 512, 8, it >> 2, 32, ep); }
    { const bool big = gridDim.x > 128; const int hb = big ? (int)blockIdx.x - 128 : (int)blockIdx.x, nh = big ? (int)gridDim.x - 128 : (int)gridDim.x;
      if (hb >= 0) { build_lora_weights(p, hb * 512 + threadIdx.x, nh * 512); prep_tiles(p, 132 * 32, 132 * 32 + 32 * 32, hb, nh); } }
}
__device__ void phase_gemm_lora(const Params& p) {
    const bf16_t* A = (const bf16_t*)(p.ws + OFF_LA);
    const bf16_t* B = (const bf16_t*)(p.ws + OFF_LB);
    Epi3 epi{p.ws, p.w0, p.a0};
    for (int L = blockIdx.x; L < 32 * 8; L += gridDim.x) { int pm, pn; unit_of(L, 32, 8, pm, pn); gemm_tile(A, B, 256, pn < 4 ? 0 : 128, 2, pm, pn, epi); }
}
__device__ void phase_gemm2(const Params& p) {
    const bf16_t* A = (const bf16_t*)(p.ws + OFF_F);
    const bf16_t* B = (const bf16_t*)(p.ws + OFF_WOUTT);
    Epi2 epi{p.x, p.out, p.final_g, (float*)(p.ws + OFF_WDAD), (unsigned*)(p.ws + OFF_FLG) + 48 * 64};
    for (int L = blockIdx.x; L < 32 * 8; L += gridDim.x) { int pm, pn; unit_of(L, 32, 8, pm, pn); gemm_tile(A, B, DM, 0, DM / BK, pm, pn, epi); }
}

__device__ __forceinline__ float tanh_fast(float x) { return 1.0f - 2.0f * __builtin_amdgcn_rcpf(__expf(2.0f * x) + 1.0f); }
__device__ __forceinline__ float bflo(unsigned u) { return __uint_as_float(u << 16); }
__device__ __forceinline__ float bfhi(unsigned u) { return __uint_as_float(u & 0xffff0000u); }

__device__ void phase_lora_in(const Params& p) {
    const int tid = threadIdx.x, lane = tid & 63, wv = tid >> 6;
    const int gw = blockIdx.x * 8 + wv, nw = gridDim.x * 8;
    const bf16_t* rkvg = (const bf16_t*)(p.ws + OFF_RKVG);
    bf16_t* la = (bf16_t*)(p.ws + OFF_LA);
    float* inv = (float*)(p.ws + OFF_SC);
    const int o = 4 * lane, sidx = o < 128 ? o : o - 32; const bool valid = (o & 127) < 96;
    const f32x4 zero4 = {0.f, 0.f, 0.f, 0.f};
    const f32x4 mu4 = valid ? *(const f32x4*)(p.mu + 4096 + sidx) : zero4;
    float muk[16], ckk[16];
#pragma unroll
    for (int j = 0; j < 16; ++j) { muk[j] = p.mu[1024 + 16 * lane + j]; ckk[j] = p.k_k[16 * lane + j]; }
    for (int t = gw; t < NTOK; t += nw) {
        const bool first = (t & (TSEQ - 1)) == 0;
        f32x4 cur = zero4, prv = zero4;
        if (valid) {
#pragma unroll
            for (int ks = 0; ks < 4; ++ks) { const float* wp = (const float*)(p.ws + wp_off(ks));
                cur += *(const f32x4*)(wp + (size_t)t * 256 + sidx);
                if (!first) prv += *(const f32x4*)(wp + (size_t)(t - 1) * 256 + sidx); }
        }
        const uint4 kc0 = *(const uint4*)(rkvg + (size_t)t * 4096 + 1024 + 16 * lane), kc1 = *(const uint4*)(rkvg + (size_t)t * 4096 + 1024 + 16 * lane + 8);
        uint4 kp0 = {0, 0, 0, 0}, kp1 = {0, 0, 0, 0};
        if (!first) { kp0 = *(const uint4*)(rkvg + (size_t)(t - 1) * 4096 + 1024 + 16 * lane); kp1 = *(const uint4*)(rkvg + (size_t)(t - 1) * 4096 + 1024 + 16 * lane + 8); }
        f32x4 m = cur + mu4 * (prv - cur);
        if (o < 128) {
#pragma unroll
            for (int j = 0; j < 4; ++j) m[j] = tanh_fast(m[j]);
        }
        uint2 w; w.x = pack2(m[0], m[1]); w.y = pack2(m[2], m[3]);
        *(uint2*)(la + (size_t)t * 256 + o) = w;
        const unsigned kcw[8] = {kc0.x, kc0.y, kc0.z, kc0.w, kc1.x, kc1.y, kc1.z, kc1.w};
        const unsigned kpw[8] = {kp0.x, kp0.y, kp0.z, kp0.w, kp1.x, kp1.y, kp1.z, kp1.w};
        float ss = 0.f;
#pragma unroll
        for (int j = 0; j < 8; ++j) {
            const float c0 = bflo(kcw[j]), c1 = bfhi(kcw[j]), p0 = bflo(kpw[j]), p1 = bfhi(kpw[j]);
            const float k0 = (c0 + muk[2 * j] * (p0 - c0)) * ckk[2 * j], k1 = (c1 + muk[2 * j + 1] * (p1 - c1)) * ckk[2 * j + 1];
            ss += k0 * k0 + k1 * k1;
        }
        ss += dpp_f<0xB1>(ss); ss += dpp_f<0x4E>(ss);
        if ((lane & 3) == 0) inv[(size_t)t * 16 + (lane >> 2)] = 1.0f / fmaxf(sqrtf(ss), 1e-12f);
    }
}

__device__ __forceinline__ void sc_publish_lds(unsigned char* g, int nbytes) {
    LAS unsigned char* lds = (LAS unsigned char*)smem_raw;
    const __amdgpu_buffer_rsrc_t rsrc = __builtin_amdgcn_make_buffer_rsrc(g, 0, nbytes, 0x00020000);
    for (int i = threadIdx.x * 16; i < nbytes; i += 512 * 16)
        __builtin_amdgcn_raw_buffer_store_b128(*(const LAS u32x4*)(lds + i), rsrc, (unsigned)i, 0,   16);
    asm volatile("s_waitcnt vmcnt(0)" ::: "memory");
}

__device__ __forceinline__ bf16x8 mk8(unsigned a, unsigned b, unsigned c, unsigned d) {
    union { unsigned u[4]; bf16x8 v; } x; x.u[0] = a; x.u[1] = b; x.u[2] = c; x.u[3] = d; return x.v;
}
#define ST_LO(ptr, u) (*(LAS bf16_t*)(ptr) = (bf16_t)((u) & 0xffffu))
#define ST_HI(ptr, u) (*(LAS bf16_t*)(ptr) = (bf16_t)((u) >> 16))
__device__ __forceinline__ int tile_off(int m, int fq, int row) { return m * 1024 + (fq * 16 + ((row + 4 * fq + m) & 15)) * 16; }
template <int PROD> __device__ void scan_hgrn_chunk(const Params& p, int bh, int pj) {
    LAS unsigned char* lds = (LAS unsigned char*)smem_raw;
    constexpr int SLOT = 13824, QF_O = 0, KF_O = 4096, AF_O = 8192, GC_O = 9216, VF_O = 9728, KT_BASE = 8 * SLOT;
    const int tid = threadIdx.x, lane = tid & 63, wv = tid >> 6, fr = lane & 15, fq = lane >> 4;
    const int b = bh >> 3, h = bh & 7;
    const size_t tb = (size_t)b * TSEQ;
    const bf16_t* Q = (const bf16_t*)(p.ws + OFF_Q) + h * 128;
    const float* F = (const float*)(p.ws + OFF_F) + h * 128;
    const bf16_t* I = (const bf16_t*)(p.ws + OFF_I) + h * 128 + wv * 16 + fr;
    const int vb = PROD == 2 ? pj * 4 + (wv & 3) : wv;
    bf16_t* YH = (bf16_t*)(p.ws + OFF_WINT) + (size_t)NTOK * 1024 + h * 128 + vb * 16 + fr;
    const bf16_t* Icol = (const bf16_t*)(p.ws + OFF_I) + h * 128;
    f32x4 Sacc[8];
#pragma unroll
    for (int i = 0; i < 8; ++i) Sacc[i] = (f32x4){0.f, 0.f, 0.f, 0.f};
    const int k0 = lane, k1 = lane + 64;
    const int qb0 = (k0 >> 5) * 1024 + ((k0 >> 2) & 3) * 256 + (((k0 >> 4) & 1) * 4 + (k0 & 3)) * 2, rot0 = 4 * ((k0 >> 2) & 3) + (k0 >> 5);
    const int qb1 = (k1 >> 5) * 1024 + ((k1 >> 2) & 3) * 256 + (((k1 >> 4) & 1) * 4 + (k1 & 3)) * 2, rot1 = 4 * ((k1 >> 2) & 3) + (k1 >> 5);
    int rdo[4];
#pragma unroll
    for (int m = 0; m < 4; ++m) rdo[m] = tile_off(m, fq, fr);
    const int ko0 = (((k0 >> 4) * 64 + (k0 & 15)) * 4) * 2, ko1 = (((k1 >> 4) * 64 + (k1 & 15)) * 4) * 2;
    unsigned short vcur[4], vnxt[4], raw_q0[16], raw_q1[16], raw_i0[16], raw_i1[16]; float raw_f0[16], raw_f1[16];
#define HG_PREFETCH(rnd) do { const size_t t0_ = tb + (size_t)((rnd) * 8 + wv) * 16; \
        _Pragma("unroll") for (int t_ = 0; t_ < 16; ++t_) { raw_q0[t_] = Q[(t0_ + t_) * 1024 + k0]; raw_q1[t_] = Q[(t0_ + t_) * 1024 + k1]; \
            raw_f0[t_] = F[(t0_ + t_) * 1024 + k0]; raw_f1[t_] = F[(t0_ + t_) * 1024 + k1]; \
            if (PROD == 1) { raw_i0[t_] = Icol[(t0_ + t_) * 1024 + k0]; raw_i1[t_] = Icol[(t0_ + t_) * 1024 + k1]; } } } while (0)
    unsigned* flg = (unsigned*)(p.ws + OFF_FLG) + (32 + bh) * 64;
    const unsigned char* ring = p.ws + OFF_RING_H + (size_t)bh * 4 * 8 * SLOT;
    constexpr int NCP = (4 * SLOT + 4095) / 4096;
    const bool stager = wv >= 4;
    u32x4 cp[NCP];
#define RING_LOADH(hr_) do { const unsigned char* s_ = ring + (size_t)((((hr_) >> 1) & 3) * 8 + ((hr_) & 1) * 4) * SLOT;     \
        _Pragma("unroll") for (int i_ = 0; i_ < NCP; ++i_) { int o_ = i_ * 4096 + (tid - 256) * 16; o_ = o_ < 4 * SLOT ? o_ : 4 * SLOT - 16; cp[i_] = *(const u32x4*)(s_ + o_); } } while (0)
#define CP_TO_LDS(hr_) do { LAS unsigned char* d_ = lds + ((hr_) & 1) * 4 * SLOT; \
        _Pragma("unroll") for (int i_ = 0; i_ < NCP; ++i_) { int o_ = i_ * 4096 + (tid - 256) * 16; o_ = o_ < 4 * SLOT ? o_ : 4 * SLOT - 16; *(LAS u32x4*)(d_ + o_) = cp[i_]; } } while (0)
    unsigned early = 0u;
    if (PROD == 2) { if (stager) { sc_wait_ge(flg + 0, 1u); __builtin_amdgcn_fence(__ATOMIC_ACQUIRE, "agent"); RING_LOADH(0); CP_TO_LDS(0); RING_LOADH(1); } }
    else HG_PREFETCH(PROD ? pj : 0);
    constexpr int NJ = PROD == 2 ? 4 : 8;
    for (int round = PROD == 1 ? pj : 0; round < (PROD == 2 ? TSEQ / 64 : TSEQ / 128); round += PROD == 1 ? 4 : 1) {
        __syncthreads();
        if (PROD == 0) {
#pragma unroll
            for (int jj = 0; jj < 4; ++jj) vcur[jj] = I[(tb + (size_t)(round * 8) * 16 + fq * 4 + jj) * 1024];
        }
        if (PROD == 2) {
            const int hr = round;
            if (stager) {
                if ((hr & 1) && tid == 256) sc_st(flg + 16 + pj, (unsigned)((hr >> 1) + 1));
                if (hr + 1 < TSEQ / 64) CP_TO_LDS(hr + 1);
                if (hr + 2 < TSEQ / 64) {
                    if (((hr + 2) & 1) == 0) { const int rn = (hr + 2) >> 1; if (early < (unsigned)(rn + 1)) sc_wait_ge(flg + (rn & 3), (unsigned)(rn + 1)); __builtin_amdgcn_fence(__ATOMIC_ACQUIRE, "agent"); }
                    RING_LOADH(hr + 2);
                    if (((hr + 2) & 1) == 0) early = sc_ld(flg + ((((hr + 2) >> 1) + 1) & 3));
                }
            }
        } else
        {
            LAS unsigned char* slot = lds + wv * SLOT; LAS unsigned char* kt = lds + KT_BASE + wv * 4096;
            float G0 = 1.f, G1 = 1.f;
            int rot0v = rot0, rot1v = rot1; asm volatile("" : "+v"(rot0v), "+v"(rot1v));
#pragma unroll
            for (int t = 0; t < 16; ++t) {
                const float q0 = bf2f(raw_q0[t]), q1 = bf2f(raw_q1[t]);
                const float f0 = raw_f0[t], f1 = raw_f1[t];
                G0 *= f0; G1 *= f1;
                const float r0 = __builtin_amdgcn_rcpf(G0), r1 = __builtin_amdgcn_rcpf(G1);
                const int qo0 = qb0 + (((t + rot0v) & 15) << 4), qo1 = qb1 + (((t + rot1v) & 15) << 4);
                const unsigned uq = cvt_pk_bf16(q0 * G0, q1 * G1), uk = cvt_pk_bf16((1.0f - f0) * r0, (1.0f - f1) * r1);
                ST_LO(slot + QF_O + qo0, uq); ST_HI(slot + QF_O + qo1, uq);
                ST_LO(kt + qo0, uk); ST_HI(kt + qo1, uk);
            }
            *(LAS float*)(slot + GC_O + k0 * 4) = G0; *(LAS float*)(slot + GC_O + k1 * 4) = G1;
            if (PROD == 1) {
#pragma unroll
                for (int s = 0; s < 16; s += 2) {
                    *(LAS unsigned*)(slot + VF_O + (((k0 >> 4) * 64 + (s >> 2) * 16 + (k0 & 15)) * 4 + (s & 3)) * 2) = (unsigned)raw_i0[s] | ((unsigned)raw_i0[s + 1] << 16);
                    *(LAS unsigned*)(slot + VF_O + (((k1 >> 4) * 64 + (s >> 2) * 16 + (k1 & 15)) * 4 + (s & 3)) * 2) = (unsigned)raw_i1[s] | ((unsigned)raw_i1[s + 1] << 16);
                }
            }
            int rot0w = rot0, rot1w = rot1; asm volatile("" : "+v"(rot0w), "+v"(rot1w));
#pragma unroll
            for (int s = 0; s < 16; ++s) {
                const float ka = bf2f(*(const LAS bf16_t*)(kt + qb0 + (((s + rot0w) & 15) << 4))), kb_ = bf2f(*(const LAS bf16_t*)(kt + qb1 + (((s + rot1w) & 15) << 4)));
                const unsigned u = cvt_pk_bf16(ka * G0, kb_ * G1);
                ST_LO(slot + KF_O + ko0 + ((s >> 2) * 16 * 4 + (s & 3)) * 2, u);
                ST_HI(slot + KF_O + ko1 + ((s >> 2) * 16 * 4 + (s & 3)) * 2, u);
            }
            *(LAS u32x2*)(slot + AF_O + lane * 16 + 8) = (u32x2){0u, 0u};
            asm volatile("s_waitcnt lgkmcnt(0)" ::: "memory");
            f32x4 d = {0.f, 0.f, 0.f, 0.f};
#pragma unroll
            for (int m = 0; m < 4; ++m) {
                const bf16x8 a = *(const LAS bf16x8*)(slot + QF_O + rdo[m]), bb = *(const LAS bf16x8*)(kt + rdo[m]);
                d = __builtin_amdgcn_mfma_f32_16x16x32_bf16(a, bb, d, 0, 0, 0);
            }
#pragma unroll
            for (int r = 0; r < 4; ++r) { const int t = fq * 4 + r, s = fr;
                const unsigned u = cvt_pk_bf16(s <= t ? d[r] : 0.f, 0.f);
                ST_LO(slot + AF_O + (((s >> 2) * 16 + t) * 8 + (s & 3)) * 2, u); }
        }
        if (PROD != 2) __syncthreads();
        if (PROD == 2) {
        } else if (PROD == 1) {
            if (round + 4 < TSEQ / 128) HG_PREFETCH(round + 4);
            if (round >= 4) { if (tid < 2) sc_wait_ge(flg + 16 + tid, (unsigned)(round - 3)); __syncthreads(); }
            sc_publish_lds(p.ws + OFF_RING_H + ((size_t)bh * 4 + pj) * 8 * SLOT, 8 * SLOT);
            __syncthreads();
            if (tid == 0) sc_st(flg + pj, (unsigned)(round + 1));
            continue;
        } else if (round + 1 < TSEQ / 128) HG_PREFETCH(round + 1);
        if (PROD == 2 && !stager) {
            bf16x8 fa[5]; u32x2 fk[8], fv; f32x4 fg[8];
#define WLDG(j_) do { LAS unsigned char* s_ = lds + ((round & 1) * 4 + (j_)) * SLOT; \
                _Pragma("unroll") for (int kb_ = 0; kb_ < 8; ++kb_) fg[kb_] = *(const LAS f32x4*)(s_ + GC_O + (kb_ * 16 + fq * 4) * 4); } while (0)
#define WLDH(A_, K_, V_, j_) do { LAS unsigned char* s_ = lds + ((round & 1) * 4 + (j_)) * SLOT; \
                _Pragma("unroll") for (int m_ = 0; m_ < 4; ++m_) A_[m_] = *(const LAS bf16x8*)(s_ + QF_O + rdo[m_]); \
                A_[4] = *(const LAS bf16x8*)(s_ + AF_O + lane * 16); \
                _Pragma("unroll") for (int kb_ = 0; kb_ < 8; ++kb_) K_[kb_] = *(const LAS u32x2*)(s_ + KF_O + (kb_ * 64 + lane) * 8); \
                V_ = *(const LAS u32x2*)(s_ + VF_O + (vb * 64 + lane) * 8); } while (0)
            WLDH(fa, fk, fv, 0); WLDG(0);
#pragma unroll
            for (int j = 0; j < NJ; ++j) {
                bf16x8 na[5]; u32x2 nk[8], nv;
                if (j + 1 < NJ) WLDH(na, nk, nv, j + 1);
                const bf16x8 Vb = mk8(fv.x, fv.y, 0u, 0u);
                f32x4 o = {0.f, 0.f, 0.f, 0.f};
#pragma unroll
                for (int m = 0; m < 4; ++m) {
                    const bf16x8 sb = mk8(cvt_pk_bf16(Sacc[2 * m][0], Sacc[2 * m][1]), cvt_pk_bf16(Sacc[2 * m][2], Sacc[2 * m][3]), cvt_pk_bf16(Sacc[2 * m + 1][0], Sacc[2 * m + 1][1]), cvt_pk_bf16(Sacc[2 * m + 1][2], Sacc[2 * m + 1][3]));
                    o = __builtin_amdgcn_mfma_f32_16x16x32_bf16(fa[m], sb, o, 0, 0, 0);
                }
                o = __builtin_amdgcn_mfma_f32_16x16x32_bf16(fa[4], Vb, o, 0, 0, 0);
#pragma unroll
                for (int kb = 0; kb < 8; ++kb) Sacc[kb] = __builtin_amdgcn_mfma_f32_16x16x32_bf16(mk8(fk[kb].x, fk[kb].y, 0u, 0u), Vb, Sacc[kb] * fg[kb], 0, 0, 0);
                if (j + 1 < NJ) WLDG(j + 1);
                { bf16_t* yo = YH + (tb + (size_t)(round * NJ + j) * 16 + fq * 4) * 1024;
                  const unsigned y01 = cvt_pk_bf16(o[0], o[1]), y23 = cvt_pk_bf16(o[2], o[3]);
                  yo[0] = (bf16_t)(y01 & 0xffffu); yo[1024] = (bf16_t)(y01 >> 16); yo[2048] = (bf16_t)(y23 & 0xffffu); yo[3072] = (bf16_t)(y23 >> 16); }
                if (j + 1 < NJ) {
#pragma unroll
                    for (int i = 0; i < 5; ++i) fa[i] = na[i];
#pragma unroll
                    for (int i = 0; i < 8; ++i) fk[i] = nk[i];
                    fv = nv;
                }
            }
#undef WLDH
#undef WLDG
        }
    }
    __syncthreads();
}


template <int PROD> __device__ void scan_rwkv_chunk(const Params& p, int bh, int pj) {
    LAS unsigned char* lds = (LAS unsigned char*)smem_raw;
    constexpr int SLOT = 12544, WA_O = 0, RT_O = 2048, MAK_O = 4096, RBK_O = 5120, KB_O = 6144, GC_O = 10240, VF_O = 10496, TMP_BASE = 8 * SLOT, TMP = 6144;
    const int tid = threadIdx.x, lane = tid & 63, wv = tid >> 6, fr = lane & 15, fq = lane >> 4;
    const int b = bh >> 4, h = bh & 15;
    const size_t tb = (size_t)b * TSEQ;
    const bf16_t* rkvg = (const bf16_t*)(p.ws + OFF_RKVG);
    const float* Wd = (const float*)(p.ws + OFF_HN);
    const bf16_t* As = (const bf16_t*)(p.ws + OFF_WINT);
    const float* invp = (const float*)(p.ws + OFF_SC);
    bf16_t* YR = (bf16_t*)(p.ws + OFF_YR) + h * 64 + wv * 16 + fr;
    const int col = h * 64 + lane;
    const float mur = p.mu[col], muk = p.mu[1024 + col], muv = p.mu[2048 + col], ckk = p.k_k[col], cka = p.k_a[col];
    const int qb = (lane >> 5) * 1024 + ((lane >> 2) & 3) * 256 + (((lane >> 4) & 1) * 4 + (lane & 3)) * 2, rot = 4 * ((lane >> 2) & 3) + (lane >> 5);
    const int rd0 = tile_off(0, fq, fr), rd1 = tile_off(1, fq, fr);
    const int kbo = KB_O + (lane >> 4) * 1024 + (lane & 15) * 16;
    const int vfo = VF_O + (((lane >> 4) * 64 + (lane & 15)) * 4) * 2;
    f32x4 Sacc[4];
#pragma unroll
    for (int i = 0; i < 4; ++i) Sacc[i] = (f32x4){0.f, 0.f, 0.f, 0.f};
    unsigned short raw_r[16], raw_k[16], raw_v[16], raw_a[16], raw_rp, raw_kp, raw_vp; float raw_w[16], raw_i[16];
#define RW_PREFETCH(rnd) do { const int c_ = (rnd) * 8 + wv; const size_t t0_ = tb + (size_t)c_ * 16; \
        raw_rp = 0; raw_kp = 0; raw_vp = 0; \
        if (c_ > 0) { const bf16_t* pr_ = rkvg + (t0_ - 1) * 4096 + col; raw_rp = pr_[0]; raw_kp = pr_[1024]; raw_vp = pr_[2048]; } \
        _Pragma("unroll") for (int t_ = 0; t_ < 16; ++t_) { const bf16_t* pr_ = rkvg + (t0_ + t_) * 4096 + col; \
            raw_r[t_] = pr_[0]; raw_k[t_] = pr_[1024]; raw_v[t_] = pr_[2048]; \
            raw_w[t_] = Wd[(t0_ + t_) * 1024 + col]; raw_a[t_] = As[(t0_ + t_) * 1024 + col]; raw_i[t_] = invp[(t0_ + t_) * 16 + h]; } } while (0)
    unsigned* flg = (unsigned*)(p.ws + OFF_FLG) + bh * 64;
    const unsigned char* ring = p.ws + OFF_RING_R + (size_t)bh * 4 * 8 * SLOT;
    constexpr int NCP = (4 * SLOT + 4095) / 4096;
    const bool stager = wv >= 4;
    u32x4 cp[NCP];
#define RING_LOAD(hr_) do { const unsigned char* s_ = ring + (size_t)((((hr_) >> 1) & 3) * 8 + ((hr_) & 1) * 4) * SLOT;     \
        _Pragma("unroll") for (int i_ = 0; i_ < NCP; ++i_) { int o_ = i_ * 4096 + (tid - 256) * 16; o_ = o_ < 4 * SLOT ? o_ : 4 * SLOT - 16; cp[i_] = *(const u32x4*)(s_ + o_); } } while (0)
#define CP_TO_LDS(hr_) do { LAS unsigned char* d_ = lds + ((hr_) & 1) * 4 * SLOT; \
        _Pragma("unroll") for (int i_ = 0; i_ < NCP; ++i_) { int o_ = i_ * 4096 + (tid - 256) * 16; o_ = o_ < 4 * SLOT ? o_ : 4 * SLOT - 16; *(LAS u32x4*)(d_ + o_) = cp[i_]; } } while (0)
    unsigned early = 0u;
    if (PROD == 2) { if (stager) { sc_wait_ge(flg + 0, 1u); __builtin_amdgcn_fence(__ATOMIC_ACQUIRE, "agent"); RING_LOAD(0); CP_TO_LDS(0); RING_LOAD(1); } }
    else RW_PREFETCH(PROD ? pj : 0);
    constexpr int NJ = PROD == 2 ? 4 : 8;
    for (int round = PROD == 1 ? pj : 0; round < (PROD == 2 ? TSEQ / 64 : TSEQ / 128); round += PROD == 1 ? 4 : 1) {
        __syncthreads();
        if (PROD == 2) {
            const int hr = round;
            if (stager) {
                if ((hr & 1) && tid == 256) sc_st(flg + 16, (unsigned)((hr >> 1) + 1));
                if (hr + 1 < TSEQ / 64) CP_TO_LDS(hr + 1);
                if (hr + 2 < TSEQ / 64) {
                    if (((hr + 2) & 1) == 0) { const int rn = (hr + 2) >> 1; if (early < (unsigned)(rn + 1)) sc_wait_ge(flg + (rn & 3), (unsigned)(rn + 1)); __builtin_amdgcn_fence(__ATOMIC_ACQUIRE, "agent"); }
                    RING_LOAD(hr + 2);
                    if (((hr + 2) & 1) == 0) early = sc_ld(flg + ((((hr + 2) >> 1) + 1) & 3));
                }
            }
        } else
        {
            LAS unsigned char* slot = lds + wv * SLOT; LAS unsigned char* tmp = lds + TMP_BASE + wv * TMP;
            float rp = bf2f(raw_rp), kp = bf2f(raw_kp), vp = bf2f(raw_vp);
            float G = 1.f, at[16], bt[16], kt[16];
            int rotv = rot; asm volatile("" : "+v"(rotv));
#pragma unroll
            for (int t = 0; t < 16; ++t) {
                const float rc = bf2f(raw_r[t]), kc = bf2f(raw_k[t]), vc = bf2f(raw_v[t]);
                const float w = raw_w[t], as = bf2f(raw_a[t]), iv = raw_i[t];
                const float r = rc + mur * (rp - rc), kx = kc + muk * (kp - kc), vm = vc + muv * (vp - vc);
                rp = rc; kp = kc; vp = vc;
                const float kkn = kx * ckk * iv, bb = kkn * as, k2 = kx * (1.0f + (as - 1.0f) * cka);
                const float Gp = G; G *= w; const float rG = __builtin_amdgcn_rcpf(G);
                const int qo = qb + (((t + rotv) & 15) << 4);
                at[t] = -kkn * Gp; bt[t] = bb * rG; kt[t] = k2 * rG;
                const unsigned u0 = cvt_pk_bf16(at[t], bt[t]), u1 = cvt_pk_bf16(kt[t], r * G), u2 = cvt_pk_bf16(vm, vm);
                ST_LO(tmp + qo, u0); ST_HI(tmp + 2048 + qo, u0);
                ST_LO(tmp + 4096 + qo, u1); ST_HI(slot + RT_O + qo, u1);
                ST_LO(slot + vfo + (t >> 2) * 128 + (t & 3) * 2, u2);
            }
            *(LAS float*)(slot + GC_O + lane * 4) = G;
#pragma unroll
            for (int s = 0; s < 16; ++s) {
                const unsigned u = cvt_pk_bf16(bt[s] * G, kt[s] * G);
                ST_LO(slot + kbo + (s >> 2) * 256 + (s & 3) * 2, u);
                ST_HI(slot + kbo + (s >> 2) * 256 + 8 + (s & 3) * 2, u);
            }
            *(LAS u32x2*)(slot + MAK_O + lane * 16) = (u32x2){0u, 0u};
            asm volatile("s_waitcnt lgkmcnt(0)" ::: "memory");
            f32x4 dab = {0.f, 0.f, 0.f, 0.f}, dak = dab, drb = dab, drk = dab;
#pragma unroll
            for (int m = 0; m < 2; ++m) {
                const int rd = m ? rd1 : rd0;
                const bf16x8 aA = *(const LAS bf16x8*)(tmp + rd), aR = *(const LAS bf16x8*)(slot + RT_O + rd);
                const bf16x8 bB = *(const LAS bf16x8*)(tmp + 2048 + rd), bK = *(const LAS bf16x8*)(tmp + 4096 + rd);
                dab = __builtin_amdgcn_mfma_f32_16x16x32_bf16(aA, bB, dab, 0, 0, 0);
                dak = __builtin_amdgcn_mfma_f32_16x16x32_bf16(aA, bK, dak, 0, 0, 0);
                drb = __builtin_amdgcn_mfma_f32_16x16x32_bf16(aR, bB, drb, 0, 0, 0);
                drk = __builtin_amdgcn_mfma_f32_16x16x32_bf16(aR, bK, drk, 0, 0, 0);
            }
            asm volatile("s_waitcnt lgkmcnt(0)" ::: "memory");
#pragma unroll
            for (int r = 0; r < 4; ++r) { const int t = fq * 4 + r, s = fr;
                *(LAS float*)(tmp + (t * 16 + s) * 4) = s < t ? dab[r] : 0.f;
                *(LAS float*)(tmp + 1024 + (t * 16 + s) * 4) = s < t ? dak[r] : 0.f;
                LAS unsigned char* rb = slot + RBK_O + (((s >> 2) * 16 + t) * 8 + (s & 3)) * 2;
                const unsigned u = cvt_pk_bf16(s <= t ? drb[r] : 0.f, s <= t ? drk[r] : 0.f);
                ST_LO(rb, u); ST_HI(rb + 8, u); }
            asm volatile("s_waitcnt lgkmcnt(0)" ::: "memory");
            float Wc[16], Mc[16];
            int rotv4 = rot; asm volatile("" : "+v"(rotv4));
#pragma unroll
            for (int t = 0; t < 16; ++t) {
                float aw = at[t], am = *(const LAS float*)(tmp + 1024 + (t * 16 + fr) * 4);
#pragma unroll
                for (int s4 = 0; s4 < (t + 3) / 4; ++s4) {
                    const f32x4 row = *(const LAS f32x4*)(tmp + (t * 16 + s4 * 4) * 4);
#pragma unroll
                    for (int e = 0; e < 4; ++e) if (s4 * 4 + e < t) { aw += row[e] * Wc[s4 * 4 + e]; am += row[e] * Mc[s4 * 4 + e]; }
                }
                Wc[t] = aw; Mc[t] = am;
                { const unsigned u = cvt_pk_bf16(aw, am);
                  ST_LO(slot + WA_O + qb + (((t + rotv4) & 15) << 4), u);
                  if (lane < 16) ST_HI(slot + MAK_O + (((lane >> 2) * 16 + t) * 8 + 4 + (lane & 3)) * 2, u); }
            }
        }
        if (PROD != 2) __syncthreads();
        if (PROD == 2) {
        } else if (PROD == 1) {
            if (round + 4 < TSEQ / 128) RW_PREFETCH(round + 4);
            if (round >= 4) { if (tid == 0) sc_wait_ge(flg + 16, (unsigned)(round - 3)); __syncthreads(); }
            sc_publish_lds(p.ws + OFF_RING_R + ((size_t)bh * 4 + pj) * 8 * SLOT, 8 * SLOT);
            __syncthreads();
            if (tid == 0) sc_st(flg + pj, (unsigned)(round + 1));
            continue;
        } else if (round + 1 < TSEQ / 128) RW_PREFETCH(round + 1);
        if (wv < 4) {
            bf16x8 fa[10]; f32x4 fg[4]; u32x2 fv;
#define WLD(A_, G_, V_, j_) do { LAS unsigned char* s_ = lds + (PROD == 2 ? (round & 1) * 4 + (j_) : (j_)) * SLOT; \
                A_[0] = *(const LAS bf16x8*)(s_ + WA_O + rd0); A_[1] = *(const LAS bf16x8*)(s_ + WA_O + rd1); A_[2] = *(const LAS bf16x8*)(s_ + RT_O + rd0); A_[3] = *(const LAS bf16x8*)(s_ + RT_O + rd1); \
                A_[4] = *(const LAS bf16x8*)(s_ + MAK_O + lane * 16); A_[5] = *(const LAS bf16x8*)(s_ + RBK_O + lane * 16); \
                _Pragma("unroll") for (int kb_ = 0; kb_ < 4; ++kb_) { A_[6 + kb_] = *(const LAS bf16x8*)(s_ + KB_O + kb_ * 1024 + lane * 16); G_[kb_] = *(const LAS f32x4*)(s_ + GC_O + (kb_ * 16 + fq * 4) * 4); } \
                V_ = *(const LAS u32x2*)(s_ + VF_O + (wv * 64 + lane) * 8); } while (0)
            WLD(fa, fg, fv, 0);
#pragma unroll
            for (int j = 0; j < NJ; ++j) {
                bf16x8 na[10]; f32x4 ng[4]; u32x2 nv;
                if (j + 1 < NJ) WLD(na, ng, nv, j + 1);
                const bf16x8 sb0 = mk8(cvt_pk_bf16(Sacc[0][0], Sacc[0][1]), cvt_pk_bf16(Sacc[0][2], Sacc[0][3]), cvt_pk_bf16(Sacc[1][0], Sacc[1][1]), cvt_pk_bf16(Sacc[1][2], Sacc[1][3]));
                const bf16x8 sb1 = mk8(cvt_pk_bf16(Sacc[2][0], Sacc[2][1]), cvt_pk_bf16(Sacc[2][2], Sacc[2][3]), cvt_pk_bf16(Sacc[3][0], Sacc[3][1]), cvt_pk_bf16(Sacc[3][2], Sacc[3][3]));
                f32x4 u = {0.f, 0.f, 0.f, 0.f}, y = u;
                u = __builtin_amdgcn_mfma_f32_16x16x32_bf16(fa[0], sb0, u, 0, 0, 0);
                u = __builtin_amdgcn_mfma_f32_16x16x32_bf16(fa[1], sb1, u, 0, 0, 0);
                u = __builtin_amdgcn_mfma_f32_16x16x32_bf16(fa[4], mk8(0u, 0u, fv.x, fv.y), u, 0, 0, 0);
                y = __builtin_amdgcn_mfma_f32_16x16x32_bf16(fa[2], sb0, y, 0, 0, 0);
                y = __builtin_amdgcn_mfma_f32_16x16x32_bf16(fa[3], sb1, y, 0, 0, 0);
                const bf16x8 uv = mk8(cvt_pk_bf16(u[0], u[1]), cvt_pk_bf16(u[2], u[3]), fv.x, fv.y);
                y = __builtin_amdgcn_mfma_f32_16x16x32_bf16(fa[5], uv, y, 0, 0, 0);
#pragma unroll
                for (int kb = 0; kb < 4; ++kb) Sacc[kb] = __builtin_amdgcn_mfma_f32_16x16x32_bf16(fa[6 + kb], uv, Sacc[kb] * fg[kb], 0, 0, 0);
                { bf16_t* yo = YR + (tb + (size_t)(round * NJ + j) * 16 + fq * 4) * 1024;
                  const unsigned y01 = cvt_pk_bf16(y[0], y[1]), y23 = cvt_pk_bf16(y[2], y[3]);
                  yo[0] = (bf16_t)(y01 & 0xffffu); yo[1024] = (bf16_t)(y01 >> 16); yo[2048] = (bf16_t)(y23 & 0xffffu); yo[3072] = (bf16_t)(y23 >> 16); }
                if (j + 1 < NJ) {
#pragma unroll
                    for (int i = 0; i < 10; ++i) fa[i] = na[i];
#pragma unroll
                    for (int i = 0; i < 4; ++i) fg[i] = ng[i];
                    fv = nv;
                }
            }
#undef WLD
        }
    }
    __syncthreads();
}


__device__ void phase_scan(const Params& p) {
    if (gridDim.x >= 256) {
        const int bi = blockIdx.x;
        if (bi < 32) scan_rwkv_chunk<2>(p, bi, 0);
        else if (bi < 64) scan_hgrn_chunk<2>(p, (bi - 32) >> 1, (bi - 32) & 1);
        else if (bi < 192) scan_rwkv_chunk<1>(p, (bi - 64) >> 2, (bi - 64) & 3);
        else scan_hgrn_chunk<1>(p, (bi - 192) >> 2, (bi - 192) & 3);
    }
    __syncthreads();
}

__device__ __forceinline__ void unpack8(const u32x4 u, float (&f)[8]) {
    f[0] = bflo(u[0]); f[1] = bfhi(u[0]); f[2] = bflo(u[1]); f[3] = bfhi(u[1]); f[4] = bflo(u[2]); f[5] = bfhi(u[2]); f[6] = bflo(u[3]); f[7] = bfhi(u[3]);
}
__device__ void phase_post(const Params& p) {
    const int tid = threadIdx.x, lane = tid & 63, wv = tid >> 6;
    const bf16_t* rkvg = (const bf16_t*)(p.ws + OFF_RKVG);
    const bf16_t* YR = (const bf16_t*)(p.ws + OFF_YR);
    const bf16_t* As = (const bf16_t*)(p.ws + OFF_WINT);
    const bf16_t* YH = (const bf16_t*)(p.ws + OFF_WINT) + (size_t)NTOK * 1024;
    const bf16_t* GH = (const bf16_t*)(p.ws + OFF_GH);
    bf16_t* Y = (bf16_t*)(p.ws + OFF_F);
    for (int gw = blockIdx.x * 8 + wv; gw < 2048; gw += gridDim.x * 8) {
        const int half = gw & 1, t0 = (gw >> 1) * 8;
        {
            const int c0 = half * 512 + lane * 8;
            float mur[8], muk[8], muv[8], mug[8], cka[8], crk[8], lw[8], lb[8];
#pragma unroll
            for (int j = 0; j < 8; ++j) { mur[j] = p.mu[c0 + j]; muk[j] = p.mu[1024 + c0 + j]; muv[j] = p.mu[2048 + c0 + j]; mug[j] = p.mu[3072 + c0 + j];
                cka[j] = p.k_a[c0 + j]; crk[j] = p.r_k[c0 + j]; lw[j] = p.lnx_w[c0 + j]; lb[j] = p.lnx_b[c0 + j]; }
            const u32x4 zero4 = {0u, 0u, 0u, 0u};
            u32x4 pr = zero4, pk = zero4, pv = zero4, pg = zero4;
            if (t0 & (TSEQ - 1)) { const bf16_t* q = rkvg + (size_t)(t0 - 1) * 4096 + c0; pr = *(const u32x4*)q; pk = *(const u32x4*)(q + 1024); pv = *(const u32x4*)(q + 2048); pg = *(const u32x4*)(q + 3072); }
#pragma unroll 1
            for (int tb4 = 0; tb4 < 8; tb4 += 2) {
                u32x4 ly[2], lr[2], lk[2], lv[2], lg[2], la[2];
#pragma unroll
                for (int i = 0; i < 2; ++i) { const size_t t = t0 + tb4 + i; const bf16_t* q = rkvg + t * 4096 + c0;
                    ly[i] = *(const u32x4*)(YR + t * 1024 + c0); lr[i] = *(const u32x4*)q; lk[i] = *(const u32x4*)(q + 1024); lv[i] = *(const u32x4*)(q + 2048); lg[i] = *(const u32x4*)(q + 3072);
                    la[i] = *(const u32x4*)(As + t * 1024 + c0); }
#pragma unroll
                for (int i = 0; i < 2; ++i) { const size_t t = t0 + tb4 + i;
                    float y[8], rc[8], kc[8], vc[8], gc[8], as[8], rp[8], kp[8], vp[8], gp[8];
                    unpack8(ly[i], y); unpack8(lr[i], rc); unpack8(lk[i], kc); unpack8(lv[i], vc); unpack8(lg[i], gc); unpack8(la[i], as);
                    unpack8(pr, rp); unpack8(pk, kp); unpack8(pv, vp); unpack8(pg, gp);
                    pr = lr[i]; pk = lk[i]; pv = lv[i]; pg = lg[i];
                    float s = ((y[0] + y[1]) + (y[2] + y[3])) + ((y[4] + y[5]) + (y[6] + y[7]));
                    s += dpp_f<0xB1>(s); s += dpp_f<0x4E>(s); s += dpp_f<0x141>(s);
                    const float mean = s * (1.0f / 64.0f);
                    float q2 = 0.f, bp = 0.f, v[8], gt[8];
#pragma unroll
                    for (int j = 0; j < 8; ++j) { y[j] -= mean; q2 += y[j] * y[j];
                        const float r = rc[j] + mur[j] * (rp[j] - rc[j]), k = kc[j] + muk[j] * (kp[j] - kc[j]);
                        v[j] = vc[j] + muv[j] * (vp[j] - vc[j]); gt[j] = gc[j] + mug[j] * (gp[j] - gc[j]);
                        bp += r * (k * (1.0f + (as[j] - 1.0f) * cka[j])) * crk[j]; }
                    q2 += dpp_f<0xB1>(q2); q2 += dpp_f<0x4E>(q2); q2 += dpp_f<0x141>(q2);
                    bp += dpp_f<0xB1>(bp); bp += dpp_f<0x4E>(bp); bp += dpp_f<0x141>(bp);
                    const float rs = rsqrtf(q2 * (1.0f / 64.0f) + 64e-5f);
                    float o[8];
#pragma unroll
                    for (int j = 0; j < 8; ++j) o[j] = (y[j] * rs * lw[j] + lb[j] + bp * v[j]) * gt[j] * sigmoidf_(gt[j]);
                    const u32x4 w = {cvt_pk_bf16(o[0], o[1]), cvt_pk_bf16(o[2], o[3]), cvt_pk_bf16(o[4], o[5]), cvt_pk_bf16(o[6], o[7])};
                    *(u32x4*)(Y + t * DM + c0) = w;
                }
            }
        }
        {
            const int c0 = half * 512 + lane * 8;
            float hg[8];
#pragma unroll
            for (int j = 0; j < 8; ++j) hg[j] = p.hg[c0 + j];
#pragma unroll 1
            for (int tb4 = 0; tb4 < 8; tb4 += 4) {
                u32x4 lo[4], lg[4];
#pragma unroll
                for (int i = 0; i < 4; ++i) { const size_t t = t0 + tb4 + i; lo[i] = *(const u32x4*)(YH + t * 1024 + c0); lg[i] = *(const u32x4*)(GH + t * 1024 + c0); }
#pragma unroll
                for (int i = 0; i < 4; ++i) { const size_t t = t0 + tb4 + i;
                    float o[8], g[8]; unpack8(lo[i], o); unpack8(lg[i], g);
                    float s = 0.f;
#pragma unroll
                    for (int j = 0; j < 8; ++j) s += o[j] * o[j];
                    s = allred16(s);
                    const float rs = rsqrtf(s * (1.0f / 128.0f) + 1e-6f);
#pragma unroll
                    for (int j = 0; j < 8; ++j) o[j] = o[j] * rs * hg[j] * g[j];
                    const u32x4 w = {cvt_pk_bf16(o[0], o[1]), cvt_pk_bf16(o[2], o[3]), cvt_pk_bf16(o[4], o[5]), cvt_pk_bf16(o[6], o[7])};
                    *(u32x4*)(Y + t * DM + 1024 + c0) = w;
                }
            }
        }
    }
}

#ifndef DUP_PHASE
#define DUP_PHASE -1
#endif
#define RUN_PHASE(N, CALL) do { if (ph_lo <= (N) && (N) <= ph_hi) { if (ph_lo < (N)) xcd_barrier(xb); CALL; if ((N) == DUP_PHASE) { xcd_barrier(xb); CALL; } } } while (0)
__global__ void __launch_bounds__(512, 2) fwd_megakernel(Params p, int ph_lo, int ph_hi) {
    cg::grid_group grid = cg::this_grid();
    if (ph_lo < 0) grid.sync();
    volatile LAS unsigned* st = (volatile LAS unsigned*)((LAS unsigned char*)smem_raw + LDS_ST);
    if (threadIdx.x == 0) { st[0] = 0u; st[1] = 0u; st[2] = 0u; st[3] = 0u; }
    __syncthreads();
    const XcdBarrier xb = xcd_barrier_post(p.bar, st);
    RUN_PHASE(0, phase_prep0(p));
    RUN_PHASE(1, phase_gemm1(p));
    RUN_PHASE(2, phase_lora_in(p));
    RUN_PHASE(3, phase_gemm_lora(p));
    RUN_PHASE(4, phase_scan(p));
    RUN_PHASE(5, phase_post(p));
    RUN_PHASE(6, phase_gemm2(p));
}

extern "C" void kernel_launch(void* const* d_in, const int* in_sizes, int n_in, void* d_out, int out_size, void* d_ws, size_t ws_size, hipStream_t stream) {
    static int grid_blocks = 0;
    if (!grid_blocks) {
        int dev = 0, cus = 0, per_cu = 0;
        hipGetDevice(&dev);
        hipDeviceGetAttribute(&cus, hipDeviceAttributeMultiprocessorCount, dev);
        hipFuncSetAttribute((const void*)fwd_megakernel, hipFuncAttributeMaxDynamicSharedMemorySize, LDS_BYTES);
        hipOccupancyMaxActiveBlocksPerMultiprocessor(&per_cu, fwd_megakernel, 512, LDS_BYTES);
        if (per_cu < 1) per_cu = 1;
        grid_blocks = cus * per_cu;
        if (grid_blocks > 256) grid_blocks = 256;
    }
    if (ws_size < WS_END) { fprintf(stderr, "workspace too small: %zu < %zu\n", ws_size, (size_t)WS_END); return; }
    Params p{};
    p.x = (const float*)d_in[0]; p.norm_g = (const float*)d_in[1]; p.w_in = (const float*)d_in[2]; p.mu = (const float*)d_in[3];
    p.w0 = (const float*)d_in[4]; p.w2 = (const float*)d_in[5]; p.a0 = (const float*)d_in[6]; p.a2 = (const float*)d_in[7];
    p.k_k = (const float*)d_in[8]; p.k_a = (const float*)d_in[9]; p.r_k = (const float*)d_in[10]; p.lnx_w = (const float*)d_in[11];
    p.lnx_b = (const float*)d_in[12]; p.hg = (const float*)d_in[13]; p.lbp = (const float*)d_in[14]; p.w_out = (const float*)d_in[15];
    p.final_g = (const float*)d_in[16];
    p.out = (float*)d_out; p.ws = (unsigned char*)d_ws; p.bar = (unsigned*)((unsigned char*)d_ws + OFF_BAR);
    hipMemsetAsync((unsigned char*)d_ws + OFF_BAR, 0, 32768, stream);
#if MK_SINGLE
    int lo = 0, hi = 6;
    void* args[] = {&p, &lo, &hi};
    hipError_t e = hipLaunchCooperativeKernel((const void*)fwd_megakernel, dim3(grid_blocks), dim3(512), args, LDS_BYTES, stream);
    if (e != hipSuccess) fprintf(stderr, "cooperative launch failed: %s (grid %d)\n", hipGetErrorString(e), grid_blocks);
#else
    for (int ph = 0; ph <= 6; ++ph) fwd_megakernel<<<dim3(grid_blocks), dim3(512), LDS_BYTES, stream>>>(p, ph, ph);
#endif
}
```
